# Optimizing an MI355X kernel written in HIP

```python
import jax, jax.numpy as jnp
from jax import lax
import numpy as np

D_MODEL = 1024
BATCH = 4
SEQ = 4096
DEPTH = 1

CHUNK = 64
ATT_HEADS = 8
HEAD_DIM = 64
ATT_WIDTH = ATT_HEADS * HEAD_DIM
LRU_WIDTH = D_MODEL - ATT_WIDTH
LRU_BLOCKS = 8
LRU_BLOCK_DIM = LRU_WIDTH // LRU_BLOCKS
CONV_WIDTH = 4
LRU_C = 8.0
Q_BLOCK = 128
N_GROUPS = 4
EXPERTS_PER_GROUP = 8
TOP_K_INNER = 2
D_EXPERT = 256
RMS_EPS = 1e-6
IN_SIZES = (ATT_WIDTH, ATT_WIDTH, ATT_WIDTH, ATT_HEADS, LRU_WIDTH, LRU_WIDTH)
IN_COLS = sum(IN_SIZES)

kernel_name = 'hymba_fox_rglru_hmoe_block'


def rmsnorm(x, g):
    xf = x.astype(jnp.float32)
    inv = lax.rsqrt(jnp.mean(xf * xf, axis=-1, keepdims=True) + RMS_EPS)
    return (xf * inv * g.astype(jnp.float32)).astype(x.dtype)


def forgetting_attention(q, k, v, log_f):
    b, s, h, dh = q.shape
    c = jnp.cumsum(log_f, axis=1).transpose(0, 2, 1)
    n_blk = s // Q_BLOCK
    q_blk = q.reshape(b, n_blk, Q_BLOCK, h, dh).transpose(1, 0, 2, 3, 4)
    c_blk = c.reshape(b, h, n_blk, Q_BLOCK).transpose(2, 0, 1, 3)
    starts = jnp.arange(n_blk, dtype=jnp.int32) * Q_BLOCK
    k_pos = jnp.arange(s, dtype=jnp.int32)
    scale = HEAD_DIM ** -0.5

    def one_block(args):
        qb, cb, start = args
        logits = jnp.einsum('bqhd,bkhd->bhqk', qb, k, preferred_element_type=jnp.float32) * scale
        decay = cb[..., :, None] - c[..., None, :]
        q_pos = start + jnp.arange(Q_BLOCK, dtype=jnp.int32)
        causal = k_pos[None, :] <= q_pos[:, None]
        logits = jnp.where(causal, logits + decay, -1e30)
        p = jax.nn.softmax(logits, axis=-1)
        return jnp.einsum('bhqk,bkhd->bqhd', p.astype(v.dtype), v)

    out = lax.map(one_block, (q_blk, c_blk, starts))
    return out.transpose(1, 0, 2, 3, 4).reshape(b, s, h * dh)


def causal_depthwise_conv(x, w, bias):
    s = x.shape[1]
    xp = jnp.pad(x, ((0, 0), (CONV_WIDTH - 1, 0), (0, 0)))
    out = bias + w[0] * xp[:, 0:s]
    for tap in range(1, CONV_WIDTH):
        out = out + w[tap] * xp[:, tap:tap + s]
    return out


def block_diag_linear(x, w, b):
    xb = x.reshape(x.shape[:-1] + (LRU_BLOCKS, LRU_BLOCK_DIM))
    y = jnp.einsum('bsni,nij->bsnj', xb, w) + b
    return y.reshape(x.shape)


def rg_lru(x, w_a, b_a, w_x, b_x, lam):
    r = jax.nn.sigmoid(block_diag_linear(x, w_a, b_a)).astype(jnp.float32)
    i = jax.nn.sigmoid(block_diag_linear(x, w_x, b_x))
    log_a = -LRU_C * r * jax.nn.softplus(-lam.astype(jnp.float32))
    a = jnp.exp(log_a)
    mult = jnp.sqrt(-jnp.expm1(2.0 * log_a))
    u = mult * (i * x).astype(jnp.float32)

    def combine(left, right):
        a_l, u_l = left
        a_r, u_r = right
        return a_r * a_l, a_r * u_l + u_r

    _, hseq = lax.associative_scan(combine, (a, u), axis=1)
    return hseq.astype(x.dtype)


def hierarchical_moe(t, w_group, b_group, w_inner, b_inner, w_gate, w_up, w_down):
    group_p = jax.nn.softmax((t @ w_group + b_group).astype(jnp.float32), axis=-1)
    g_w, g_idx = lax.top_k(group_p, 1)
    inner_all = jnp.einsum('nd,gde->nge', t, w_inner) + b_inner
    inner_logits = jnp.take_along_axis(inner_all, g_idx[:, :, None], axis=1)[:, 0]
    inner_p = jax.nn.softmax(inner_logits.astype(jnp.float32), axis=-1)
    e_w, e_idx = lax.top_k(inner_p, TOP_K_INNER)
    e_w = e_w / jnp.sum(e_w, axis=-1, keepdims=True)
    expert_w = jnp.sum(jax.nn.one_hot(e_idx, EXPERTS_PER_GROUP, dtype=jnp.float32) * e_w[..., None], axis=1)
    combine = (g_w[:, :, None]
               * jax.nn.one_hot(g_idx[:, 0], N_GROUPS, dtype=jnp.float32)[:, :, None]
               * expert_w[:, None, :]).astype(t.dtype)
    y = jnp.zeros_like(t)
    for g in range(N_GROUPS):
        hg = jax.nn.silu(jnp.einsum('nd,edf->nef', t, w_gate[g])) * jnp.einsum('nd,edf->nef', t, w_up[g])
        y = y + jnp.einsum('nef,efd->nd', hg * combine[:, g, :, None], w_down[g])
    return y


def setup_inputs(seed: int = 0) -> dict:
    key = jax.random.key(seed)
    ks = jax.random.split(key, 24)
    nrm = jax.random.normal
    L, D, G, E, F = DEPTH, D_MODEL, N_GROUPS, EXPERTS_PER_GROUP, D_EXPERT
    a0 = jax.random.uniform(ks[10], (L, LRU_WIDTH), minval=0.9, maxval=0.999)
    sig = a0 ** (1.0 / LRU_C)
    lam = jnp.log(sig) - jnp.log1p(-sig)
    return {
        'x': nrm(ks[0], (BATCH, SEQ, D), jnp.float32),
        'mix_norm': 1.0 + 0.05 * nrm(ks[1], (L, D), jnp.float32),
        'w_in': nrm(ks[2], (L, D, IN_COLS), jnp.float32) * D ** -0.5,
        'b_forget': jnp.linspace(1.0, 6.0, ATT_HEADS, dtype=jnp.float32) + 0.1 * nrm(ks[3], (L, ATT_HEADS), jnp.float32),
        'conv_w': nrm(ks[4], (L, CONV_WIDTH, LRU_WIDTH), jnp.float32) * CONV_WIDTH ** -0.5,
        'conv_b': 0.02 * nrm(ks[5], (L, LRU_WIDTH), jnp.float32),
        'w_a': nrm(ks[6], (L, LRU_BLOCKS, LRU_BLOCK_DIM, LRU_BLOCK_DIM), jnp.float32) * LRU_BLOCK_DIM ** -0.5,
        'b_a': 0.02 * nrm(ks[7], (L, LRU_BLOCKS, LRU_BLOCK_DIM), jnp.float32),
        'w_x': nrm(ks[8], (L, LRU_BLOCKS, LRU_BLOCK_DIM, LRU_BLOCK_DIM), jnp.float32) * LRU_BLOCK_DIM ** -0.5,
        'b_x': 0.02 * nrm(ks[9], (L, LRU_BLOCKS, LRU_BLOCK_DIM), jnp.float32),
        'lru_lambda': lam,
        'w_out': nrm(ks[11], (L, D, D), jnp.float32) * D ** -0.5,
        'ffn_norm': 1.0 + 0.05 * nrm(ks[12], (L, D), jnp.float32),
        'w_group': nrm(ks[13], (L, D, G), jnp.float32) * D ** -0.5,
        'b_group': 0.01 * nrm(ks[14], (L, G), jnp.float32),
        'w_inner': nrm(ks[15], (L, G, D, E), jnp.float32) * D ** -0.5,
        'b_inner': 0.01 * nrm(ks[16], (L, G, E), jnp.float32),
        'w_gate': nrm(ks[17], (L, G, E, D, F), jnp.float32) * D ** -0.5,
        'w_up': nrm(ks[18], (L, G, E, D, F), jnp.float32) * D ** -0.5,
        'w_down': nrm(ks[19], (L, G, E, F, D), jnp.float32) * F ** -0.5,
        'final_norm': 1.0 + 0.05 * nrm(ks[20], (D,), jnp.float32),
    }


def reference(x, mix_norm, w_in, b_forget, conv_w, conv_b, w_a, b_a, w_x, b_x, lru_lambda,
              w_out, ffn_norm, w_group, b_group, w_inner, b_inner, w_gate, w_up, w_down, final_norm):
    b, s, d = x.shape
    split_points = [int(v) for v in np.cumsum(IN_SIZES)[:-1]]
    for l in range(DEPTH):
        h = rmsnorm(x, mix_norm[l])
        z = h @ w_in[l]
        q, k, v, f_logit, gate_in, rec_in = jnp.split(z, split_points, axis=-1)
        log_f = jax.nn.log_sigmoid(f_logit.astype(jnp.float32) + b_forget[l].astype(jnp.float32))
        att = forgetting_attention(q.reshape(b, s, ATT_HEADS, HEAD_DIM),
                                   k.reshape(b, s, ATT_HEADS, HEAD_DIM),
                                   v.reshape(b, s, ATT_HEADS, HEAD_DIM), log_f)
        rec = causal_depthwise_conv(rec_in, conv_w[l], conv_b[l])
        rec = rg_lru(rec, w_a[l], b_a[l], w_x[l], b_x[l], lru_lambda[l])
        lru_out = rec * jax.nn.gelu(gate_in, approximate=True)
        x = x + jnp.concatenate([att, lru_out], axis=-1) @ w_out[l]
        h2 = rmsnorm(x, ffn_norm[l]).reshape(b * s, d)
        y = hierarchical_moe(h2, w_group[l], b_group[l], w_inner[l], b_inner[l],
                             w_gate[l], w_up[l], w_down[l])
        x = x + y.reshape(b, s, d)
    return rmsnorm(x, final_norm)
```

```cpp
#include <hip/hip_runtime.h>
#include <hip/hip_bf16.h>
#include <cstdio>
#include <cstdint>
#include <cmath>
namespace pg8 {
#define PG8_LAS __attribute__((address_space(3)))
typedef unsigned short bf16_t;
typedef short bf16x8 __attribute__((ext_vector_type(8)));
typedef float f32x4 __attribute__((ext_vector_type(4)));
typedef unsigned u32x4 __attribute__((ext_vector_type(4)));
constexpr int BM = 256, BK = 64, HALF = 128, HTB = HALF * BK * 2  , STAGE_BYTES = 8 * HTB, NXCD = 8, WGM = 8;

__host__ __device__ __forceinline__ int lds_byte(int r, int c) { const int st = (r >> 4) * 2 + (c >> 5), rr = r & 15, cc = c & 31, ob = rr * 64 + cc * 2; return st * 1024 + (ob ^ (((ob >> 9) & 1) << 5)); }
__host__ __device__ __forceinline__ void stage_rc(int b, int& R, int& C) { const int st = b / 1024, sb = b % 1024, swz = sb ^ (((sb >> 9) & 1) << 5); R = (st >> 1) * 16 + swz / 64; C = (st & 1) * 32 + (swz % 64) / 2; }
__host__ __device__ __forceinline__ int perm32(int rho) { const int n = rho >> 4, i = rho & 15; return 8 * (i >> 2) + 4 * n + (i & 3); }

struct Unit { int pm, pn; };
struct Gemm { const bf16_t* A; const bf16_t* Bt; int M, N, K; };

struct StaticOrder {
    int nM, nN, nwg, G, c;
    __host__ __device__ void init(int M, int N, int G_, int c_) { nM = M / BM; nN = N / BM; nwg = nM * nN; G = G_; c = c_; }
    __host__ __device__ bool next(int i, Unit& u) const {
        const long L = (long)i * G + c; if (L >= nwg) return false;
        int wgid = (int)L; { const int q = nwg / NXCD, r = nwg % NXCD, xcd = wgid % NXCD, off = wgid / NXCD; wgid = (xcd < r ? xcd * (q + 1) : r * (q + 1) + (xcd - r) * q) + off; }
        const int nig = WGM * nN, gid = wgid / nig, fm = gid * WGM, gsz = (nM - fm) < WGM ? (nM - fm) : WGM;
        u.pm = fm + ((wgid % nig) % gsz); u.pn = (wgid % nig) / gsz; return true;
    }
    __device__ __forceinline__ void a_ready(const Unit&) const {}
    __device__ __forceinline__ void done(const Unit&) const {}
};

__device__ __forceinline__ unsigned cvt_pk_bf16(float lo, float hi) { unsigned r; asm volatile("v_cvt_pk_bf16_f32 %0, %1, %2" : "=v"(r) : "v"(lo), "v"(hi)); return r; }
__device__ __forceinline__ float gelu_fast(float x) {
    const float t = x * (1.5957691216057308f + 0.07135481627260025f * x * x);
    return x * __builtin_amdgcn_rcpf(1.0f + __builtin_amdgcn_exp2f(-1.4426950408889634f * t));
}
struct EpiInProj {
    static constexpr bool PERM = true, AFTER_DRAIN = false;
    bf16_t *q, *k, *v, *gg, *ri; float* lf; const float* bfg; const float* rinv;
    __device__ __forceinline__ void operator()(const f32x4 (&acc)[2][2][4][2], const Unit& u, int wr, int wc, int fr, int fq) const {
        const int seg = u.pn >> 1;
        const int row0 = u.pm * BM + wr * 64 + fr;
        if (seg < 5) {
            bf16_t* base = seg == 0 ? q : seg == 1 ? k : seg == 2 ? v : seg == 3 ? gg : ri;
            const int col0 = (u.pn & 1) * 256 + wc * 32 + 8 * fq;
#pragma unroll
            for (int ai = 0; ai < 2; ++ai)
#pragma unroll
                for (int m = 0; m < 4; ++m) { bf16_t* rowp = base + (size_t)(row0 + ai * HALF + m * 16) * 512 + col0; const float rv = rinv[row0 + ai * HALF + m * 16] * (seg == 0 ? 0.18033688011112042f : 1.0f);
#pragma unroll
                    for (int bj = 0; bj < 2; ++bj) { f32x4 v0 = acc[ai][bj][m][0] * rv, v1 = acc[ai][bj][m][1] * rv;
                        if (seg == 3) { v0 = (f32x4){gelu_fast(v0[0]), gelu_fast(v0[1]), gelu_fast(v0[2]), gelu_fast(v0[3])}; v1 = (f32x4){gelu_fast(v1[0]), gelu_fast(v1[1]), gelu_fast(v1[2]), gelu_fast(v1[3])}; }
                        u32x4 w; w.x = cvt_pk_bf16(v0[0], v0[1]); w.y = cvt_pk_bf16(v0[2], v0[3]); w.z = cvt_pk_bf16(v1[0], v1[1]); w.w = cvt_pk_bf16(v1[2], v1[3]);
                        *(u32x4*)(rowp + bj * HALF) = w; } }
        } else if (wc == 0) {
            if (fq == 0) {
#pragma unroll
                for (int ai = 0; ai < 2; ++ai)
#pragma unroll
                    for (int m = 0; m < 4; ++m) { const int row = row0 + ai * HALF + m * 16; const int b = row >> 12, s = row & 4095;
#pragma unroll
                        for (int n = 0; n < 2; ++n)
#pragma unroll
                            for (int j = 0; j < 4; ++j) { const int h = 4 * n + j; const float z = acc[ai][0][m][n][j] * rinv[row] + bfg[h];
                                lf[((size_t)(b * 8 + h) << 12) + s] = fminf(z, 0.f) - 0.6931471805599453f * __builtin_amdgcn_logf(1.0f + __builtin_amdgcn_exp2f(-1.4426950408889634f * fabsf(z))); } }
            }
        }
    }
};
struct EpiOutProj {
    static constexpr bool PERM = true, AFTER_DRAIN = false;
    const bf16_t* x; bf16_t* x1; float* ssqp;
    __device__ __forceinline__ void operator()(const f32x4 (&acc)[2][2][4][2], const Unit& u, int wr, int wc, int fr, int fq) const {
        const int row0 = u.pm * BM + wr * 64 + fr, col0 = u.pn * BM + wc * 32 + 8 * fq;
#pragma unroll
        for (int ai = 0; ai < 2; ++ai)
#pragma unroll
            for (int m = 0; m < 4; ++m) { const int row = row0 + ai * HALF + m * 16; const size_t off = (size_t)row * 1024 + col0; float s = 0.f;
#pragma unroll
                for (int bj = 0; bj < 2; ++bj) { const u32x4 xw = *(const u32x4*)(x + off + bj * HALF);
                    const f32x4 xa = (f32x4){__uint_as_float(xw.x << 16), __uint_as_float(xw.x & 0xffff0000u), __uint_as_float(xw.y << 16), __uint_as_float(xw.y & 0xffff0000u)};
                    const f32x4 xb = (f32x4){__uint_as_float(xw.z << 16), __uint_as_float(xw.z & 0xffff0000u), __uint_as_float(xw.w << 16), __uint_as_float(xw.w & 0xffff0000u)};
                    const f32x4 o0 = xa + acc[ai][bj][m][0], o1 = xb + acc[ai][bj][m][1];
                    u32x4 w; w.x = cvt_pk_bf16(o0[0], o0[1]); w.y = cvt_pk_bf16(o0[2], o0[3]); w.z = cvt_pk_bf16(o1[0], o1[1]); w.w = cvt_pk_bf16(o1[2], o1[3]);
                    *(u32x4*)(x1 + off + bj * HALF) = w;
                    s += ((o0[0] * o0[0] + o0[1] * o0[1]) + (o0[2] * o0[2] + o0[3] * o0[3])) + ((o1[0] * o1[0] + o1[1] * o1[1]) + (o1[2] * o1[2] + o1[3] * o1[3])); }
                s += __shfl_xor(s, 16); s += __shfl_xor(s, 32);
                if (fq == 0) ssqp[(size_t)row * 16 + u.pn * 4 + wc] = s;
                if (m & 1) asm volatile("" ::: "memory"); }
    }
};
template <class Epi, class Sched, bool ALIGN_EPI = false, bool SP2 = false>
__device__ __forceinline__ void gemm_phase(PG8_LAS unsigned char* lds, const Gemm g, const Sched& S, const Epi& E) {
    const int tid = threadIdx.x, wid = __builtin_amdgcn_readfirstlane(tid >> 6), lane = tid & 63, wr = wid >> 2, wc = wid & 3, fr = lane & 15, fq = lane >> 4;
    const int K = g.K, nt = K / BK;
    unsigned voffA[2], voffB[2];
#pragma unroll
    for (int i = 0; i < 2; ++i) { int R, C; stage_rc(tid * 16 + i * 8192, R, C); const int Rb = Epi::PERM ? ((R & ~31) + perm32(R & 31)) : R;
        voffA[i] = (unsigned)(R * K + C) * 2u; voffB[i] = (unsigned)(Rb * K + C) * 2u; }
    const size_t kstep = (size_t)(BK * 2);
    const size_t hstep = (size_t)HALF * K * 2;
    const size_t tstep = 2 * hstep;
    const unsigned ldsw = (unsigned)wid * 1024u;
    const int aoff = lds_byte(wr * 64 + fr, fq * 8), boff = lds_byte(wc * 32 + fr, fq * 8);
#define PG8_SA(b, h) (((b) * 2 + (h)) * HTB)
#define PG8_SB(b, h) ((4 + (b) * 2 + (h)) * HTB)
#define PG8_STAGE(bufoff, gbase, voff) do { _Pragma("unroll") for (int _i = 0; _i < 2; ++_i) \
        __builtin_amdgcn_global_load_lds((const unsigned*)((const char*)(gbase) + (voff)[_i]), (PG8_LAS unsigned*)(lds + (bufoff) + ldsw + _i * 8192), 16, 0, 0); } while (0)
#define PG8_LDA(dst, b, h) do { _Pragma("unroll") for (int m = 0; m < 4; ++m) _Pragma("unroll") for (int k = 0; k < 2; ++k) dst[m][k] = *(const PG8_LAS bf16x8*)(lds + PG8_SA(b, h) + aoff + m * 2048 + k * 1024); } while (0)
#define PG8_LDB(dst, b, h) do { _Pragma("unroll") for (int n = 0; n < 2; ++n) _Pragma("unroll") for (int k = 0; k < 2; ++k) dst[n][k] = *(const PG8_LAS bf16x8*)(lds + PG8_SB(b, h) + boff + n * 2048 + k * 1024); } while (0)
#define PG8_MMA(ai, bj, At, Bt) do { __builtin_amdgcn_s_setprio(1); _Pragma("unroll") for (int m = 0; m < 4; ++m) _Pragma("unroll") for (int n = 0; n < 2; ++n) _Pragma("unroll") for (int k = 0; k < 2; ++k) \
        acc[ai][bj][m][n] = __builtin_amdgcn_mfma_f32_16x16x32_bf16(Bt[n][k], At[m][k], acc[ai][bj][m][n], 0, 0, 0); __builtin_amdgcn_s_setprio(0); } while (0)
#define PG8_WAIT_V(n) asm volatile("s_waitcnt vmcnt(" #n ")" ::: "memory")
#define PG8_WAIT_L(n) asm volatile("s_waitcnt lgkmcnt(" #n ")" ::: "memory")
#define PG8_BAR __builtin_amdgcn_s_barrier()
#define PG8_SCHED __builtin_amdgcn_sched_barrier(0)
    Unit cur, nxt; int ui = 0;
    if (!S.next(0, cur)) return;
    f32x4 acc[2][2][4][2];
#pragma unroll
    for (int a = 0; a < 2; ++a)
#pragma unroll
        for (int b = 0; b < 2; ++b)
#pragma unroll
            for (int m = 0; m < 4; ++m)
#pragma unroll
                for (int n = 0; n < 2; ++n) acc[a][b][m][n] = (f32x4){0.f, 0.f, 0.f, 0.f};
    bf16x8 At[4][2], B0[2][2], B1[2][2];
    const char* cA = (const char*)g.A + (size_t)cur.pm * tstep; const char* cB = (const char*)g.Bt + (size_t)cur.pn * tstep;
    S.a_ready(cur);
    if constexpr (SP2) {
        PG8_STAGE(PG8_SB(0, 0), cB, voffB); PG8_STAGE(PG8_SB(0, 1), cB + hstep, voffB); PG8_STAGE(PG8_SA(0, 0), cA, voffA); PG8_STAGE(PG8_SA(0, 1), cA + hstep, voffA);
        if (wr == 1) PG8_BAR;
        PG8_WAIT_V(2); PG8_BAR;
        PG8_STAGE(PG8_SB(1, 0), cB + kstep, voffB); PG8_STAGE(PG8_SA(1, 0), cA + kstep, voffA); PG8_STAGE(PG8_SB(1, 1), cB + hstep + kstep, voffB);
        PG8_WAIT_V(6); PG8_BAR;
    } else {
        PG8_STAGE(PG8_SB(0, 0), cB, voffB); PG8_STAGE(PG8_SA(0, 0), cA, voffA); PG8_STAGE(PG8_SB(0, 1), cB + hstep, voffB); PG8_STAGE(PG8_SA(0, 1), cA + hstep, voffA);
        if (wr == 1) PG8_BAR;
        PG8_WAIT_V(4); PG8_BAR;
        PG8_STAGE(PG8_SB(1, 0), cB + kstep, voffB); PG8_STAGE(PG8_SA(1, 0), cA + kstep, voffA); PG8_STAGE(PG8_SB(1, 1), cB + hstep + kstep, voffB);
        PG8_WAIT_V(6); PG8_BAR;
    }
    for (;;) {
        const bool has_next = S.next(ui + 1, nxt);
        const char* nA = has_next ? (const char*)g.A + (size_t)nxt.pm * tstep : cA; const char* nB = has_next ? (const char*)g.Bt + (size_t)nxt.pn * tstep : cB;
        for (int t = 0; t < nt; t += 2) {
            const bool last = (t == nt - 2);
            const char* a1 = cA + (size_t)(t + 1) * kstep;
            const char* a2 = last ? nA : cA + (size_t)(t + 2) * kstep; const char* b2 = last ? nB : cB + (size_t)(t + 2) * kstep;
            const char* a3 = a2 + kstep; const char* b3 = b2 + kstep;
            if (last && has_next) S.a_ready(nxt);
            if constexpr (SP2) {
            PG8_LDB(B0, 0, 0); PG8_LDB(B1, 0, 1); PG8_SCHED; PG8_LDA(At, 0, 0); PG8_STAGE(PG8_SA(1, 1), a1 + hstep, voffA);
            PG8_WAIT_V(8); PG8_WAIT_L(0); PG8_BAR; PG8_MMA(0, 0, At, B0); PG8_MMA(0, 1, At, B1); PG8_BAR; PG8_SCHED;
            PG8_LDA(At, 0, 1); PG8_STAGE(PG8_SB(0, 0), b2, voffB); PG8_STAGE(PG8_SB(0, 1), b2 + hstep, voffB); PG8_STAGE(PG8_SA(0, 0), a2, voffA);
            PG8_WAIT_V(8); PG8_WAIT_L(0); PG8_BAR; PG8_MMA(1, 0, At, B0); PG8_MMA(1, 1, At, B1); PG8_BAR; PG8_SCHED;
            PG8_LDB(B0, 1, 0); PG8_LDB(B1, 1, 1); PG8_SCHED; PG8_LDA(At, 1, 0); PG8_STAGE(PG8_SA(0, 1), a2 + hstep, voffA);
            PG8_WAIT_V(8); PG8_WAIT_L(0); PG8_BAR; PG8_MMA(0, 0, At, B0); PG8_MMA(0, 1, At, B1); PG8_BAR; PG8_SCHED;
            PG8_LDA(At, 1, 1); PG8_STAGE(PG8_SB(1, 0), b3, voffB); PG8_STAGE(PG8_SB(1, 1), b3 + hstep, voffB); PG8_STAGE(PG8_SA(1, 0), a3, voffA);
            PG8_WAIT_V(8); PG8_WAIT_L(0); PG8_BAR; PG8_MMA(1, 0, At, B0); PG8_MMA(1, 1, At, B1); PG8_BAR; PG8_SCHED;
            } else {
            PG8_LDB(B0, 0, 0); PG8_SCHED; PG8_LDA(At, 0, 0); PG8_STAGE(PG8_SA(1, 1), a1 + hstep, voffA);
            PG8_WAIT_L(8); PG8_BAR; PG8_WAIT_L(0); PG8_MMA(0, 0, At, B0); PG8_BAR; PG8_SCHED;
            PG8_LDB(B1, 0, 1); PG8_STAGE(PG8_SB(0, 0), b2, voffB);
            PG8_BAR; PG8_WAIT_L(0); PG8_MMA(0, 1, At, B1); PG8_BAR;
            PG8_LDA(At, 0, 1); PG8_STAGE(PG8_SA(0, 0), a2, voffA);
            PG8_BAR; PG8_WAIT_L(0); PG8_MMA(1, 0, At, B0); PG8_BAR; PG8_SCHED;
            PG8_STAGE(PG8_SB(0, 1), b2 + hstep, voffB);
            PG8_WAIT_V(6); PG8_BAR; PG8_MMA(1, 1, At, B1); PG8_BAR;
            PG8_LDB(B0, 1, 0); PG8_SCHED; PG8_LDA(At, 1, 0); PG8_STAGE(PG8_SA(0, 1), a2 + hstep, voffA);
            PG8_WAIT_L(8); PG8_BAR; PG8_WAIT_L(0); PG8_MMA(0, 0, At, B0); PG8_BAR; PG8_SCHED;
            PG8_LDB(B1, 1, 1); PG8_STAGE(PG8_SB(1, 0), b3, voffB);
            PG8_BAR; PG8_WAIT_L(0); PG8_MMA(0, 1, At, B1); PG8_BAR;
            PG8_LDA(At, 1, 1); PG8_STAGE(PG8_SA(1, 0), a3, voffA);
            PG8_BAR; PG8_WAIT_L(0); PG8_MMA(1, 0, At, B0); PG8_BAR; PG8_SCHED;
            PG8_STAGE(PG8_SB(1, 1), b3 + hstep, voffB);
            PG8_WAIT_V(6); PG8_BAR; PG8_MMA(1, 1, At, B1); PG8_BAR;
            }
        }
        if constexpr (ALIGN_EPI) { if (wr == 0) PG8_BAR; }
        if constexpr (!Epi::AFTER_DRAIN) { E(acc, cur, wr, wc, fr, fq); S.done(cur); }
        if (!has_next) break;
#pragma unroll
        for (int a = 0; a < 2; ++a)
#pragma unroll
            for (int b = 0; b < 2; ++b)
#pragma unroll
                for (int m = 0; m < 4; ++m)
#pragma unroll
                    for (int n = 0; n < 2; ++n) acc[a][b][m][n] = (f32x4){0.f, 0.f, 0.f, 0.f};
        cur = nxt; cA = nA; cB = nB; ++ui;
        if constexpr (ALIGN_EPI) { if (wr == 1) PG8_BAR; }
    }
    PG8_WAIT_V(0);
    if constexpr (!ALIGN_EPI) { if (wr == 0) PG8_BAR; }
    PG8_BAR;
    if constexpr (Epi::AFTER_DRAIN) { E.fused(acc, cur, wr, wc, fr, fq, lds, wid, lane); S.done(cur); }
#undef PG8_SA
#undef PG8_SB
#undef PG8_STAGE
#undef PG8_LDA
#undef PG8_LDB
#undef PG8_MMA
#undef PG8_WAIT_V
#undef PG8_WAIT_L
#undef PG8_BAR
#undef PG8_SCHED
}
}
#define GAS __attribute__((address_space(1)))
#define LAS __attribute__((address_space(3)))
typedef unsigned short bf16_t;
typedef unsigned v4u __attribute__((ext_vector_type(4)));
typedef float f32x4 __attribute__((ext_vector_type(4)));
typedef float f32x16 __attribute__((ext_vector_type(16)));
typedef short bf16x8 __attribute__((ext_vector_type(8)));
#define LDS_WAIT() asm volatile("s_waitcnt lgkmcnt(0)" ::: "memory")
#define VM_WAIT() asm volatile("s_waitcnt vmcnt(0)" ::: "memory")
__device__ __forceinline__ unsigned f2bfu(float f) { unsigned u = __builtin_bit_cast(unsigned, f); return (u + 0x7fffu + ((u >> 16) & 1u)) >> 16; }
__device__ __forceinline__ unsigned pk2(float lo, float hi) { return f2bfu(lo) | (f2bfu(hi) << 16); }
__device__ __forceinline__ float bf2f(bf16_t v) { return __uint_as_float(((unsigned)v) << 16); }
__device__ __forceinline__ bf16_t f2bf(float f) { return (bf16_t)f2bfu(f); }
__device__ __forceinline__ int fresh_lane() { int l; asm volatile("v_mbcnt_lo_u32_b32 %0, -1, 0\n\tv_mbcnt_hi_u32_b32 %0, -1, %0" : "=v"(l)); return l; }
__device__ __forceinline__ float wave_sum(float v) {
#pragma unroll
    for (int o = 1; o < 64; o <<= 1) v += __shfl_xor(v, o);
    return v;
}
constexpr int NTOK = 16384, SEQ = 4096, DM = 1024, NB = 4, NH = 8, INC = 2568, NIN = 2816;
constexpr float LOG2E = 1.4426950408889634f;
constexpr size_t MiB = 1u << 20;
constexpr size_t WS_CTL = 0, CTL_ZERO_BYTES = 1 * MiB;
constexpr size_t WS_WIN = 1 * MiB;
constexpr size_t WS_WOUT = 7 * MiB;
constexpr size_t WS_W1F = 9 * MiB;
constexpr size_t WS_W2F = 41 * MiB;
constexpr size_t WS_WLRU = 57 * MiB;
constexpr size_t WS_WR = 57 * MiB + 512 * 1024;
constexpr size_t WS_HN = 58 * MiB;
constexpr size_t WS_AO = WS_HN;
constexpr size_t WS_Q = 90 * MiB, WS_K = 106 * MiB, WS_V = 122 * MiB, WS_GG = 138 * MiB, WS_RI = 154 * MiB;
constexpr size_t WS_XG = 90 * MiB;
constexpr size_t WS_Y = 122 * MiB;
constexpr size_t WS_X1 = 186 * MiB;
constexpr size_t WS_LF = 250 * MiB;
constexpr size_t WS_C2 = 250 * MiB + 512 * 1024;
constexpr size_t WS_SSQP = 251 * MiB;
constexpr size_t WS_RT = 252 * MiB;
constexpr size_t WS_SUM = 252 * MiB + 512 * 1024;
constexpr size_t WS_LIST = 253 * MiB + 512 * 1024;
constexpr size_t WS_END = 256 * MiB;
constexpr int CW_BAR = 4096;
constexpr int CW_CNT = 32768;
constexpr int RING_BYTES = 131072, LDS_BYTES = 147456, MISC_OFF = LDS_BYTES - 512, LDSCTL_OFF = LDS_BYTES - 1024;
#define XB_TMO      128
#define XB_XCNT(j)  (256  + 64 * (j))
#define XB_XSUB(j)  (1280 + 64 * (j))
#define XB_XGEN(j)  (2304 + 64 * (j))
#define XB_TOP      3328
#define XB_TOPGEN   3392
#define XCD_BAR_WORDS 3456
#define XB_SPIN_CAP (1u << 18)

__device__ __forceinline__ unsigned xb_ld(unsigned* p)              { return __hip_atomic_load(p, __ATOMIC_RELAXED, __HIP_MEMORY_SCOPE_AGENT); }
__device__ __forceinline__ unsigned xb_add(unsigned* p, unsigned v) { return __hip_atomic_fetch_add(p, v, __ATOMIC_RELAXED, __HIP_MEMORY_SCOPE_AGENT); }
__device__ __forceinline__ unsigned xb_xcc_id() { return (unsigned)__builtin_amdgcn_s_getreg((3 << 11) | 20) & 0xFu; }
#define XB_SPIN(cond, bar) do { unsigned _sp = 0; while (cond) { __builtin_amdgcn_s_sleep(1); \
    if ((++_sp & 255u) == 0u) { if (xb_ld(&(bar)[XB_TMO])) break; if (_sp > XB_SPIN_CAP) { atomicAdd(&(bar)[XB_TMO], 1u); break; } } } } while (0)

struct XcdBarrier {
    unsigned* bar; unsigned x;
    volatile LAS unsigned* st;
};

__device__ __forceinline__ XcdBarrier xcd_barrier_post(unsigned* bar, volatile LAS unsigned* st) {
    XcdBarrier b; b.bar = bar; b.x = xb_xcc_id(); b.st = st;
    if (threadIdx.x == 0) (void)xb_add(&bar[XB_XCNT(b.x)], 1u);
    return b;
}
__device__ __forceinline__ void xcd_barrier_complete(unsigned* bar, unsigned x, unsigned& nloc, unsigned& nx) {
    const unsigned G = gridDim.x * gridDim.y * gridDim.z;
    unsigned sum, cnt, mine, sp = 0u;
    for (;;) {
        sum = 0u; cnt = 0u; mine = 0u;
#pragma unroll
        for (unsigned j = 0; j < 16; ++j) { const unsigned c = xb_ld(&bar[XB_XCNT(j)]); sum += c; cnt += (c > 0u) ? 1u : 0u; mine = (j == x) ? c : mine; }
        if (sum == G) break;
        __builtin_amdgcn_s_sleep(1);
        if ((++sp & 255u) == 0u) { if (xb_ld(&bar[XB_TMO])) break; if (sp > XB_SPIN_CAP) { atomicAdd(&bar[XB_TMO], 1u); break; } }
    }
    nloc = mine > 0u ? mine : 1u; nx = cnt > 0u ? cnt : 1u;
}

__device__ __forceinline__ void xcd_barrier(const XcdBarrier& b) {
    asm volatile("s_waitcnt vmcnt(0)" ::: "memory");
    __syncthreads();
    if (threadIdx.x == 0) {
        unsigned* bar = b.bar;
        __builtin_amdgcn_s_waitcnt(0);
        unsigned nloc = b.st[0], nx = b.st[1];
        if (nloc == 0u) { xcd_barrier_complete(bar, b.x, nloc, nx); b.st[0] = nloc; b.st[1] = nx; }
        const unsigned old = xb_add(&bar[XB_XSUB(b.x)], 1u);
        const unsigned gen = old / nloc;
        if (old + 1u == (gen + 1u) * nloc) {
            __builtin_amdgcn_fence(__ATOMIC_RELEASE, "agent");
            asm volatile("s_waitcnt vmcnt(0)" ::: "memory");
            const unsigned og = xb_add(&bar[XB_TOP], 1u);
            const unsigned tg = og / nx;
            if (og + 1u == (tg + 1u) * nx) xb_add(&bar[XB_TOPGEN], 1u);
            else XB_SPIN(xb_ld(&bar[XB_TOPGEN]) == tg, bar);
            __builtin_amdgcn_fence(__ATOMIC_ACQUIRE, "agent");
            xb_add(&bar[XB_XGEN(b.x)], 1u);
            asm volatile("s_waitcnt vmcnt(0)" ::: "memory");
        } else {
            XB_SPIN(xb_ld(&bar[XB_XGEN(b.x)]) == gen, bar);
            __builtin_amdgcn_fence(__ATOMIC_ACQUIRE, "agent");
            asm volatile("s_waitcnt vmcnt(0)" ::: "memory");
        }
    }
    __syncthreads();
}
#include <hip/hip_bf16.h>
namespace attn_body {
using bf16=__hip_bfloat16;
using bf16x8=__attribute__((ext_vector_type(8)))short;
using s16x4=__attribute__((ext_vector_type(4)))short;
using f32x16=__attribute__((ext_vector_type(16)))float;
using u32x4=__attribute__((ext_vector_type(4)))unsigned;
using u32x2=__attribute__((ext_vector_type(2)))unsigned;
constexpr int BATCH=4,NHEAD=8,SEQ=4096,D=64,DM=NHEAD*D,OPITCH=1024;
constexpr int NW=8,QBLK=32,QB=QBLK*NW,KVBLK=64,NQB=SEQ/QB;
constexpr int ATTN_PITCH=DM, ATTN_UNIT_ROWS=QB;
__device__ __forceinline__ int crow(int r,int hi){return (r&3)+8*(r>>2)+4*hi;}
#define SBAR() __builtin_amdgcn_sched_barrier(0)
__device__ __forceinline__ void cmask(f32x16&p0,f32x16&p1,int jb,int qrel,int hi){
  const float NEG=-INFINITY; int kb=64*jb+4*hi;
  #pragma unroll
  for(int r=0;r<16;++r){int kv=kb+(r&3)+8*(r>>2); if(kv>qrel)p0[r]=NEG; if(kv+32>qrel)p1[r]=NEG;}
}

constexpr int NSLOT=3, SLOTB=8192;
constexpr int LDS_K=0, LDS_V=NSLOT*SLOTB, LDS_WS=2*NSLOT*SLOTB, LDS_OST=LDS_WS+NW*64*4, LDS_BYTES=LDS_OST+NW*4096; constexpr int LDS_CK=LDS_BYTES, LDS_CKW=LDS_CK+SEQ*4, LDS_KA=LDS_CKW+64, LDS_TOTAL=LDS_KA+SEQ*8;
constexpr float C2=0.125f*1.4426950408889634f;
__device__ __forceinline__ void glds16(const void*gsrc,unsigned lds_dst){unsigned keep;
  asm volatile("s_mov_b32 %0, m0\n\ts_mov_b32 m0, %2\n\ts_nop 0\n\tglobal_load_lds_dwordx4 %1, off\n\ts_mov_b32 m0, %0":"=&s"(keep):"v"(gsrc),"s"(lds_dst):"memory");}
__device__ __forceinline__ float max3f(float a,float b,float c){float r;asm("v_max3_f32 %0, %1, %2, %3":"=v"(r):"v"(a),"v"(b),"v"(c));return r;}
__device__ __forceinline__ float max2f(float a,float b){float r;asm("v_max_f32_e32 %0, %1, %2":"=v"(r):"v"(a),"v"(b));return r;}
__device__ __forceinline__ float fadd_s(float a,float b){float r;asm("v_add_f32_e32 %0, %1, %2":"=v"(r):"v"(a),"v"(b));return r;}
__device__ __forceinline__ float fsub_s(float a,float b){float r;asm("v_sub_f32_e32 %0, %1, %2":"=v"(r):"v"(a),"v"(b));return r;}
typedef float f32x2_t __attribute__((ext_vector_type(2))); typedef __bf16 bf16x2_t __attribute__((ext_vector_type(2)));
__device__ __forceinline__ unsigned cvtpk_s(float lo,float hi){f32x2_t v={lo,hi};bf16x2_t b=__builtin_convertvector(v,bf16x2_t);return __builtin_bit_cast(unsigned,b);}
#define WAIT_BAR(N) asm volatile("s_waitcnt vmcnt(" #N ") lgkmcnt(0)\n\ts_barrier":::"memory")

__device__ __forceinline__ void qkt(f32x16&p0,f32x16&p1,const char*Kslot,const bf16x8*qr,int r32,int hi){
  const char*kb=Kslot+hi*1024+r32*16;
  #pragma unroll
  for(int d0=0;d0<4;++d0){
    const bf16x8 b0=*reinterpret_cast<const bf16x8*>(kb+d0*2048);
    const bf16x8 b1=*reinterpret_cast<const bf16x8*>(kb+d0*2048+512);
    p0=__builtin_amdgcn_mfma_f32_32x32x16_bf16(b0,qr[d0],p0,0,0,0);p1=__builtin_amdgcn_mfma_f32_32x32x16_bf16(b1,qr[d0],p1,0,0,0);}
}
typedef __attribute__((address_space(3))) const char* lds_cptr;
typedef short v4i16_t __attribute__((ext_vector_type(4)));
__device__ __forceinline__ void kload8(bf16x8*kf,lds_cptr kp){
  kf[0]=*(const __attribute__((address_space(3))) bf16x8*)(kp);      kf[1]=*(const __attribute__((address_space(3))) bf16x8*)(kp+512);
  kf[2]=*(const __attribute__((address_space(3))) bf16x8*)(kp+2048); kf[3]=*(const __attribute__((address_space(3))) bf16x8*)(kp+2560);
  kf[4]=*(const __attribute__((address_space(3))) bf16x8*)(kp+4096); kf[5]=*(const __attribute__((address_space(3))) bf16x8*)(kp+4608);
  kf[6]=*(const __attribute__((address_space(3))) bf16x8*)(kp+6144); kf[7]=*(const __attribute__((address_space(3))) bf16x8*)(kp+6656);
}
__device__ __forceinline__ void kload2(bf16x8*kf,lds_cptr kp,int j){ kf[2*j]=*(const __attribute__((address_space(3))) bf16x8*)(kp+j*2048); kf[2*j+1]=*(const __attribute__((address_space(3))) bf16x8*)(kp+j*2048+512); }
__device__ __forceinline__ s16x4 vtr(lds_cptr p){ return __builtin_bit_cast(s16x4,__builtin_amdgcn_ds_read_tr16_b64_v4i16((__attribute__((address_space(3))) v4i16_t*)p)); }
__device__ __forceinline__ float rowmax(const f32x16&p0,const f32x16&p1){
  float a=max3f(p0[0],p0[1],p1[0]),b=max3f(p0[2],p0[3],p1[1]);a=max3f(a,p1[2],p1[3]);
  #pragma unroll
  for(int r=4;r<16;r+=4){a=max3f(a,p0[r],p0[r+1]);b=max3f(b,p0[r+2],p0[r+3]);a=max3f(a,p1[r],p1[r+1]);b=max3f(b,p1[r+2],p1[r+3]);}
  const float m=max2f(a,b);
  auto rr=__builtin_amdgcn_permlane32_swap(__float_as_uint(m),__float_as_uint(m),false,false);
  return max2f(__uint_as_float(rr[0]),__uint_as_float(rr[1]));
}
__device__ __forceinline__ void pv(f32x16*o,int vb,bf16x8 pa0,bf16x8 pa1,bf16x8 pa2,bf16x8 pa3){
  #pragma unroll
  for(int d0=0;d0<2;++d0){s16x4 lo[4],hi[4];
    #pragma unroll
    for(int ks=0;ks<4;++ks){
      asm volatile("ds_read_b64_tr_b16 %0,%1 offset:%c2":"=&v"(lo[ks]):"v"(vb),"i"(d0*4096+ks*1024):"memory");
      asm volatile("ds_read_b64_tr_b16 %0,%1 offset:%c2":"=&v"(hi[ks]):"v"(vb),"i"(d0*4096+ks*1024+512):"memory");}
    asm volatile("s_waitcnt lgkmcnt(0)":::"memory");SBAR();
    #define PK(k) (bf16x8){lo[k][0],lo[k][1],lo[k][2],lo[k][3],hi[k][0],hi[k][1],hi[k][2],hi[k][3]}
    o[d0]=__builtin_amdgcn_mfma_f32_32x32x16_bf16(pa0,PK(0),o[d0],0,0,0);
    o[d0]=__builtin_amdgcn_mfma_f32_32x32x16_bf16(pa1,PK(1),o[d0],0,0,0);
    o[d0]=__builtin_amdgcn_mfma_f32_32x32x16_bf16(pa2,PK(2),o[d0],0,0,0);
    o[d0]=__builtin_amdgcn_mfma_f32_32x32x16_bf16(pa3,PK(3),o[d0],0,0,0);
    #undef PK
  }
}

#ifndef ATTN_STORE16
#define ATTN_STORE16(p,v) (*(u32x4*)(p)=(v))
#endif
template<int THRL> __device__ __forceinline__ void attn_unit(int b,int h,int qb,const bf16*Q,const bf16*__restrict__ K,const bf16*__restrict__ V,bf16*O,const float*LF,char*shm,bool build_ck){
  const int tid=threadIdx.x,lane=tid&63,r32=lane&31,hi=lane>>5; const int wid=__builtin_amdgcn_readfirstlane(tid>>6);
  const long rowbase=(long)b*SEQ; const int q0=qb*QB;
  if(build_ck){ const int n=q0+QB; const float*lfp=LF+(size_t)(b*NHEAD+h)*SEQ; const int r0=tid*8;
    typedef float f4_t __attribute__((ext_vector_type(4)));
    float v[8];
    if(r0<n){ const f4_t a=*(const f4_t*)(lfp+(n-8-r0)), c=*(const f4_t*)(lfp+(n-4-r0)); v[0]=c[3];v[1]=c[2];v[2]=c[1];v[3]=c[0];v[4]=a[3];v[5]=a[2];v[6]=a[1];v[7]=a[0]; }
    else { _Pragma("unroll") for(int i=0;i<8;++i)v[i]=0.f; }
    float e[8]; e[0]=0.f; _Pragma("unroll") for(int i=1;i<8;++i)e[i]=e[i-1]+v[i-1];
    const float tot=e[7]+v[7]; float x=tot;
    int lo_=lane; asm volatile("":"+v"(lo_));
    _Pragma("unroll") for(int o=1;o<64;o<<=1){ const float y=__int_as_float(__builtin_amdgcn_ds_bpermute((lo_-o)<<2,__float_as_int(x))); if(lo_>=o)x+=y; }
    __attribute__((address_space(3))) float*ckw=(__attribute__((address_space(3))) float*)((lds_cptr)shm+LDS_CKW);
    __attribute__((address_space(3))) float*ckp=(__attribute__((address_space(3))) float*)((lds_cptr)shm+LDS_CK);
    if(lo_==63)ckw[wid]=x;
    asm volatile("s_waitcnt lgkmcnt(0)\n\ts_barrier":::"memory");
    float base=0.f; _Pragma("unroll") for(int w=0;w<8;++w){ const float tw=ckw[w]; if(w<wid)base+=tw; }
    const float ex=base+(x-tot);
    __attribute__((address_space(3))) u32x2*kap=(__attribute__((address_space(3))) u32x2*)((lds_cptr)shm+LDS_KA);
    if(r0<n){ _Pragma("unroll") for(int i=0;i<8;++i){ const float xv=-1.4426950408889634f*(ex+e[i]); ckp[n-1-r0-i]=xv;
      const unsigned ph=cvtpk_s(xv,0.f)&0xffffu; const float r1=xv-__uint_as_float(ph<<16); const unsigned pm=cvtpk_s(r1,0.f)&0xffffu; const float r2=r1-__uint_as_float(pm<<16); const unsigned pl=cvtpk_s(r2,0.f)&0xffffu;
      kap[n-1-r0-i]=(u32x2){ph|(pm<<16),pl|0x3F800000u}; } }
    asm volatile("s_waitcnt lgkmcnt(0)\n\ts_barrier":::"memory");
  }
  const bf16*Qw=Q+(rowbase+q0+wid*QBLK)*DM+h*D;
  const bf16*Kh=K+rowbase*DM+h*D,*Vh=V+rowbase*DM+h*D;
  const unsigned lds0=(unsigned)(uintptr_t)shm;
  float*wsf=(float*)(shm+LDS_WS)+wid*64;
  const bf16*ksrc=Kh+(long)lane*DM+wid*8;
  const bf16*vsrc=Vh+(long)(16*(wid&3)+(lane>>2))*DM+(wid>>2)*32+(lane&3)*8;
  const unsigned kdst=lds0+LDS_K+wid*1024, vdst=lds0+LDS_V+wid*1024;
  #define DMA_K(t,slot) glds16(ksrc+(long)(t)*KVBLK*DM,(unsigned)__builtin_amdgcn_readfirstlane(kdst+(slot)))
  #define DMA_V(t,slot) glds16(vsrc+(long)(t)*KVBLK*DM,(unsigned)__builtin_amdgcn_readfirstlane(vdst+(slot)))
  const int vb0=(int)(lds0+LDS_V)+((lane>>4)&1)*32+(lane&3)*8+(4*hi+((lane&15)>>2))*64;
  const char*Kbase=shm+LDS_K; bf16x8 kf[8];
  const lds_cptr shm3=(lds_cptr)shm; const lds_cptr kp0=shm3+LDS_K+hi*1024+r32*16; const lds_cptr vp0=shm3+LDS_V+((lane>>4)&1)*32+(lane&3)*8+(4*hi+((lane&15)>>2))*64;
  const int NT=(q0+QB)/KVBLK;
  DMA_K(0,0);DMA_V(0,0);DMA_K(1,SLOTB);
  bf16x8 qr[4];
  #pragma unroll
  for(int d0=0;d0<4;++d0)qr[d0]=*reinterpret_cast<const bf16x8*>(&Qw[(long)r32*DM+d0*16+hi*8]);
  float mhat=0.f,l_reg=0.f;f32x16 o[2];o[0]=f32x16{};o[1]=f32x16{};
  const int qrel=wid*QBLK+r32;
  typedef float f4_t __attribute__((ext_vector_type(4)));
  const __attribute__((address_space(3))) float*ckb=(const __attribute__((address_space(3))) float*)((lds_cptr)shm+LDS_CK);
  const float cq=ckb[q0+qrel];
  const __attribute__((address_space(3))) u32x2*kab=(const __attribute__((address_space(3))) u32x2*)((lds_cptr)shm+LDS_KA)+r32;
  u32x4 qaug; u32x2 kaw0,kaw1; const f32x16 z16=f32x16{};
  #define QAUG() do{ const float a_=cq-mhat; const unsigned ph_=cvtpk_s(a_,0.f)&0xffffu; const float r1_=a_-__uint_as_float(ph_<<16); const unsigned pm_=cvtpk_s(r1_,0.f)&0xffffu; \
    const unsigned pl_=cvtpk_s(r1_-__uint_as_float(pm_<<16),0.f)&0xffffu; qaug=hi?(u32x4){0u,0u,0u,0u}:(u32x4){0xBF80BF80u,0xBF80u|(ph_<<16),pm_|(pl_<<16),0u}; }while(0)
  #define KAL(tt) do{ kaw0=kab[64*(tt)]; kaw1=kab[64*(tt)+32]; }while(0)
  #define KAF(w) __builtin_bit_cast(bf16x8,(u32x4){w[0],w[1],0x3F803F80u,0u})
  #define QAF __builtin_bit_cast(bf16x8,qaug)
  #define AUGM(X0,X1) do{ X0=__builtin_amdgcn_mfma_f32_32x32x16_bf16(KAF(kaw0),QAF,z16,0,0,0); X1=__builtin_amdgcn_mfma_f32_32x32x16_bf16(KAF(kaw1),QAF,z16,0,0,0); }while(0)
  #define CMASK(P0,P1,t) do{int jb_=(t)-(NT-4); if(jb_>=0)cmask(P0,P1,jb_,qrel,hi);}while(0)
  bool resc=false;
  #define START(P0,P1) do{ const float rm=rowmax(P0,P1); resc=false; \
    { const float dl=rm; mhat=fadd_s(mhat,dl); \
      _Pragma("unroll") for(int r=0;r<16;++r){P0[r]=fsub_s(P0[r],dl);P1[r]=fsub_s(P1[r],dl);} } \
    _Pragma("unroll") for(int r=0;r<16;++r)P0[r]=__builtin_amdgcn_exp2f(P0[r]); }while(0)
  #define RESC() do{ if(resc){ asm volatile("s_waitcnt lgkmcnt(0)":::"memory"); \
      _Pragma("unroll") for(int d_=0;d_<2;++d_) _Pragma("unroll") for(int r=0;r<16;++r)o[d_][r]*=wsf[crow(r,hi)]; } }while(0)
  f32x16 pA0,pA1,pB0,pB1;
  int sl_prev=0,sl_cur=0,sl_next=SLOTB;
  #define ROT() do{sl_prev=sl_cur;sl_cur=sl_next;sl_next=(sl_next==(NSLOT-1)*SLOTB)?0:sl_next+SLOTB;}while(0)
  DMA_K(2,2*SLOTB);
  WAIT_BAR(3);
  QAUG(); KAL(0); AUGM(pA0,pA1);
  qkt(pA0,pA1,Kbase,qr,r32,hi);asm volatile("s_nop 15\n\ts_nop 7":"+v"(pA0),"+v"(pA1));CMASK(pA0,pA1,0);
  START(pA0,pA1);
  QAUG(); KAL(1); AUGM(pB0,pB1);
  _Pragma("unroll") for(int r=0;r<16;++r)pA1[r]=__builtin_amdgcn_exp2f(pA1[r]);
  WAIT_BAR(0);
  DMA_K(3,0);DMA_V(1,SLOTB);
  ROT();
  kload8(kf,kp0+sl_cur);
  WAIT_BAR(2);
  s16x4 vlo[8],vhi[8]; u32x4 pw0,pw1,pw2,pw3;
  #define PKW(P,B) cvtpk_s(P[B],P[B+1])
  #define PAF(k) __builtin_bit_cast(bf16x8,pw##k)
  #define VFR(i) (bf16x8){vlo[i][0],vlo[i][1],vlo[i][2],vlo[i][3],vhi[i][0],vhi[i][1],vhi[i][2],vhi[i][3]}
  #define PIN(x) asm volatile("":"+v"(x))
  #define MX3(a,b,c) __builtin_fmaxf(__builtin_fmaxf((a),(b)),(c))
  #define GAPA(MF,A0,A1,A2,A3,W0,W1,PW) do{ MF; sacc+=A0; sacc+=A1; sacc+=A2; sacc+=A3; PIN(sacc); W0; W1; PIN(PW); SBAR(); }while(0)
  #define EX(v) __builtin_amdgcn_exp2f(v)
  #define GAPB(MF,X,B) do{ MF; X[B]=EX(X[B]); X[B+1]=EX(X[B+1]); X[B+2]=EX(X[B+2]); X[B+3]=EX(X[B+3]); PIN(X); SBAR(); }while(0)
  #define VRD(i) do{ vlo[i]=vtr(vp_+(((i)>>2)*4096+((i)&3)*1024)); vhi[i]=vtr(vp_+(((i)>>2)*4096+((i)&3)*1024+512)); }while(0)
  #define KRD(G,j) do{ if(G){ kload2(kf,kp0+sl_next,j); SBAR(); } }while(0)
  #define STEP(C0,C1,P0,P1,t,GK,GV,GL,GI) do{ SBAR(); \
    const lds_cptr vp_=vp0+sl_prev; \
    if(GI){ KAL((t)+1); } \
    VRD(0); SBAR(); float sacc=(P0[0]+P0[1]); \
    GAPA(C0=__builtin_amdgcn_mfma_f32_32x32x16_bf16(kf[0],qr[0],C0,0,0,0), P0[2],P0[3],P0[4],P0[5],     pw0[0]=PKW(P0,0), pw0[1]=PKW(P0,2), pw0); \
    VRD(4); SBAR(); GAPA(C1=__builtin_amdgcn_mfma_f32_32x32x16_bf16(kf[1],qr[0],C1,0,0,0), P0[6],P0[7],P0[8],P0[9],     pw0[2]=PKW(P0,4), pw0[3]=PKW(P0,6), pw0); \
    VRD(1); SBAR(); GAPA(C0=__builtin_amdgcn_mfma_f32_32x32x16_bf16(kf[2],qr[1],C0,0,0,0),   P0[10],P0[11],P0[12],P0[13], pw1[0]=PKW(P0,8), pw1[1]=PKW(P0,10), pw1); \
    VRD(5); SBAR(); GAPA(C1=__builtin_amdgcn_mfma_f32_32x32x16_bf16(kf[3],qr[1],C1,0,0,0),   P0[14],P0[15],P1[0],P1[1],   pw1[2]=PKW(P0,12),pw1[3]=PKW(P0,14), pw1); \
    VRD(2); SBAR(); GAPA(C0=__builtin_amdgcn_mfma_f32_32x32x16_bf16(kf[4],qr[2],C0,0,0,0),   P1[2],P1[3],P1[4],P1[5],     pw2[0]=PKW(P1,0), pw2[1]=PKW(P1,2), pw2); \
    VRD(6); SBAR(); GAPA(C1=__builtin_amdgcn_mfma_f32_32x32x16_bf16(kf[5],qr[2],C1,0,0,0),   P1[6],P1[7],P1[8],P1[9],     pw2[2]=PKW(P1,4), pw2[3]=PKW(P1,6), pw2); \
    VRD(3); SBAR(); GAPA(C0=__builtin_amdgcn_mfma_f32_32x32x16_bf16(kf[6],qr[3],C0,0,0,0),   P1[10],P1[11],P1[12],P1[13], pw3[0]=PKW(P1,8), pw3[1]=PKW(P1,10), pw3); \
    VRD(7); SBAR(); GAPA(C1=__builtin_amdgcn_mfma_f32_32x32x16_bf16(kf[7],qr[3],C1,0,0,0),   P1[14],P1[15],0.f,0.f,       pw3[2]=PKW(P1,12),pw3[3]=PKW(P1,14), pw3); \
    l_reg+=sacc; \
    if(GK){DMA_K((t)+3,sl_cur);} if(GV){DMA_V((t)+1,sl_next);} \
    CMASK(C0,C1,t); \
    { float a=MX3(C0[0],C0[1],C1[0]),b=MX3(C0[2],C0[3],C1[1]); a=MX3(a,C1[2],C1[3]); \
      _Pragma("unroll") for(int r=4;r<16;r+=4){a=MX3(a,C0[r],C0[r+1]);b=MX3(b,C0[r+2],C0[r+3]);a=MX3(a,C1[r],C1[r+1]);b=MX3(b,C1[r+2],C1[r+3]);} \
      float rm=__builtin_fmaxf(a,b); { auto rr=__builtin_amdgcn_permlane32_swap(__float_as_uint(rm),__float_as_uint(rm),false,false); rm=__builtin_fmaxf(__uint_as_float(rr[0]),__uint_as_float(rr[1])); } \
      resc=false; \
      if(__builtin_expect(__any(rm>(float)THRL),0)){ const float dl=__builtin_fmaxf(rm,0.f); mhat+=dl; QAUG(); \
        _Pragma("unroll") for(int r=0;r<16;++r){C0[r]-=dl;C1[r]-=dl;} \
        const float f=__builtin_amdgcn_exp2f(-dl); l_reg*=f; if(hi==0)wsf[r32]=f; resc=true; } } \
    if(GI){ AUGM(P0,P1); } \
    SBAR(); \
    GAPB(o[0]=__builtin_amdgcn_mfma_f32_32x32x16_bf16(PAF(0),VFR(0),o[0],0,0,0), C0,0); \
    GAPB(o[1]=__builtin_amdgcn_mfma_f32_32x32x16_bf16(PAF(0),VFR(4),o[1],0,0,0), C0,4); \
    KRD(GL,0); GAPB(o[0]=__builtin_amdgcn_mfma_f32_32x32x16_bf16(PAF(1),VFR(1),o[0],0,0,0), C0,8); \
    KRD(GL,1); GAPB(o[1]=__builtin_amdgcn_mfma_f32_32x32x16_bf16(PAF(1),VFR(5),o[1],0,0,0), C0,12); \
    KRD(GL,2); GAPB(o[0]=__builtin_amdgcn_mfma_f32_32x32x16_bf16(PAF(2),VFR(2),o[0],0,0,0), C1,0); \
    KRD(GL,3); GAPB(o[1]=__builtin_amdgcn_mfma_f32_32x32x16_bf16(PAF(2),VFR(6),o[1],0,0,0), C1,4); \
    GAPB(o[0]=__builtin_amdgcn_mfma_f32_32x32x16_bf16(PAF(3),VFR(3),o[0],0,0,0), C1,8); \
    GAPB(o[1]=__builtin_amdgcn_mfma_f32_32x32x16_bf16(PAF(3),VFR(7),o[1],0,0,0), C1,12); \
    }while(0)
  int t=1;
  #undef CMASK
  #define CMASK(P0,P1,t) do{}while(0)
  for(;t+5<NT;t+=2){
    STEP(pB0,pB1,pA0,pA1,t,true,true,true,true);     WAIT_BAR(2); RESC(); ROT();
    STEP(pA0,pA1,pB0,pB1,t+1,true,true,true,true);   WAIT_BAR(2); RESC(); ROT();
  }
  #undef CMASK
  #define CMASK(P0,P1,t) do{int jb_=(t)-(NT-4); if(jb_>=0)cmask(P0,P1,jb_,qrel,hi);}while(0)
  #define ENDW(tt) do{ if((tt)+3<NT){WAIT_BAR(2);} else if((tt)+2<NT){WAIT_BAR(1);} else {WAIT_BAR(0);} }while(0)
  for(;t+1<NT;t+=2){
    STEP(pB0,pB1,pA0,pA1,t,(t+3<NT),(t+1<NT),(t+1<NT),(t+1<NT));       ENDW(t);   RESC(); ROT();
    STEP(pA0,pA1,pB0,pB1,t+1,(t+4<NT),(t+2<NT),(t+2<NT),(t+2<NT));     ENDW(t+1); RESC(); ROT();
  }
  STEP(pB0,pB1,pA0,pA1,NT-1,false,false,false,false); RESC();
  { float sacc=pB0[0]+pB0[1]; _Pragma("unroll") for(int r=2;r<16;++r)sacc+=pB0[r]; _Pragma("unroll") for(int r=0;r<16;++r)sacc+=pB1[r]; l_reg+=sacc;
    pw0=(u32x4){PKW(pB0,0),PKW(pB0,2),PKW(pB0,4),PKW(pB0,6)};pw1=(u32x4){PKW(pB0,8),PKW(pB0,10),PKW(pB0,12),PKW(pB0,14)};pw2=(u32x4){PKW(pB1,0),PKW(pB1,2),PKW(pB1,4),PKW(pB1,6)};pw3=(u32x4){PKW(pB1,8),PKW(pB1,10),PKW(pB1,12),PKW(pB1,14)};
    SBAR(); pv(o,vb0+sl_cur,PAF(0),PAF(1),PAF(2),PAF(3)); }
  #undef PKW
  #undef PAF
  #undef VFR
  #undef PIN
  #undef MX3
  #undef GAPA
  #undef GAPB
  #undef EX
  #undef VRD
  #undef KRD
  #undef STEP
  #undef ENDW
  {auto rr=__builtin_amdgcn_permlane32_swap(__float_as_uint(l_reg),__float_as_uint(l_reg),false,false);l_reg=__uint_as_float(rr[0])+__uint_as_float(rr[1]);}
  if(hi==0)wsf[32+r32]=l_reg;asm volatile("s_waitcnt lgkmcnt(0)":::"memory");
  float rli[16];
  #pragma unroll
  for(int r=0;r<16;++r)rli[r]=__builtin_amdgcn_rcpf(wsf[32+crow(r,hi)]);
  bf16*Ow=O+(rowbase+q0+wid*QBLK)*OPITCH+h*D;
  { bf16*stg=(bf16*)(shm+LDS_OST)+wid*2048;
    #pragma unroll
    for(int r=0;r<16;++r){const int orow=crow(r,hi);
      #pragma unroll
      for(int d0=0;d0<2;++d0)stg[orow*64+d0*32+r32]=__float2bfloat16(o[d0][r]*rli[r]);}
    asm volatile("s_waitcnt lgkmcnt(0)":::"memory");
    #pragma unroll
    for(int i=0;i<4;++i){const int row=i*8+(lane>>3),ch=lane&7; const u32x4 v=*(const u32x4*)(stg+row*64+ch*8); ATTN_STORE16(Ow+(long)row*OPITCH+ch*8,v);} }
  asm volatile("s_waitcnt lgkmcnt(0)\n\ts_barrier":::"memory");
  #undef DMA_K
  #undef DMA_V
  #undef CMASK
  #undef START
  #undef RESC
  #undef ROT
  #undef QAUG
  #undef KAL
  #undef KAF
  #undef QAF
  #undef AUGM
}
constexpr int ATTN_LDS_BYTES=LDS_TOTAL;
struct AttnTensors { const bf16* Q; const bf16* K; const bf16* V; bf16* O; const float* LF; };
struct AttnUnit { int bh; int qb; };
struct StaticOrder {
  int vcu;
  __device__ __forceinline__ explicit StaticOrder(int grid,int block):vcu((block%8)*(grid/8)+block/8){}
  __device__ __forceinline__ bool next(int i,AttnUnit&u)const{ if(i>=2)return false; const int s=vcu&7; u.bh=vcu>>3; u.qb=(i==0)?15-s:s; return true; }
  __device__ __forceinline__ void a_ready(const AttnUnit&)const{}
  __device__ __forceinline__ void done(const AttnUnit&)const{}
};
template<class Sched,int THRL=8> __device__ __forceinline__ void attn_phase(char*lds,const AttnTensors&T,const Sched&S){
  AttnUnit u;
  for(int i=0;S.next(i,u);++i){ S.a_ready(u); attn_unit<THRL>(u.bh/NHEAD,u.bh%NHEAD,u.qb,T.Q,T.K,T.V,T.O,T.LF,lds,i==0); S.done(u); }
}
#undef SBAR
#undef WAIT_BAR
}
__device__ __forceinline__ void p0_transpose_item(const float* W, int K, int ldw, int src_col0, int nvalid, bf16_t* WT, int n0, int k0, LAS float* scr, int lane, const float* kgain) {
#pragma unroll 8
    for (int i = 0; i < 32; ++i) { const int kk = 2 * i + (lane >> 5), l = lane & 31; scr[kk * 33 + l] = (l < nvalid) ? W[(size_t)(k0 + kk) * ldw + src_col0 + l] * (kgain ? kgain[k0 + kk] : 1.0f) : 0.f; }
    LDS_WAIT(); asm volatile("" ::: "memory");
    const int c = lane & 7;
#pragma unroll
    for (int j = 0; j < 4; ++j) { const int n = (lane >> 3) + 8 * j; const LAS float* s = scr + (8 * c) * 33 + n;
        v4u o; o.x = pk2(s[0 * 33], s[1 * 33]); o.y = pk2(s[2 * 33], s[3 * 33]); o.z = pk2(s[4 * 33], s[5 * 33]); o.w = pk2(s[6 * 33], s[7 * 33]);
        *(GAS v4u*)(WT + (size_t)(n0 + n) * K + k0 + 8 * c) = o; }
    LDS_WAIT(); asm volatile("" ::: "memory");
}
__device__ __forceinline__ void row_to_bf16_inv(const float* xrow, bf16_t* orow, float* invp, int lane) {
    const GAS f32x4* xr = (const GAS f32x4*)xrow + lane;
    f32x4 v[4]; float s = 0.f;
#pragma unroll
    for (int j = 0; j < 4; ++j) { v[j] = xr[64 * j]; s += (v[j].x * v[j].x + v[j].y * v[j].y) + (v[j].z * v[j].z + v[j].w * v[j].w); }
    const float inv = 1.0f / sqrtf(wave_sum(s) * (1.f / DM) + 1e-6f);
    GAS unsigned long long* o8 = (GAS unsigned long long*)orow + lane;
#pragma unroll
    for (int j = 0; j < 4; ++j) o8[64 * j] = (unsigned long long)pk2(v[j].x, v[j].y) | ((unsigned long long)pk2(v[j].z, v[j].w) << 32);
    if (lane == 0) *invp = inv;
}
namespace lru {
constexpr int ROWB = 144, TILE_B = 67 * ROWB  , CW_OFF = 9728, WAVE_LDS = 11264;
__device__ __forceinline__ float fast_sigmoid(float z) { return __builtin_amdgcn_rcpf(1.0f + __builtin_amdgcn_exp2f(-1.4426950408889634f * z)); }
__device__ __forceinline__ void stage1(int item, int wave, int lane, LAS unsigned char* Lw, const bf16_t* ri, const bf16_t* wlru, const float* cw, const float* cb,
                                       const float* ba, const float* bx, const float* lam, float* sumP, float* sumH, f32x16 (&Pc)[2][2], f32x16 (&Hl)[2][2]) {
    const int b = item >> 6, c = item & 63, t0 = c * 64; const size_t n0 = (size_t)b * SEQ + t0;
    const int r32 = lane & 31, hi = lane >> 5, chb = wave * 64;
#pragma unroll
    for (int pass = 0; pass < 9; ++pass) { const int row = pass * 8 + (lane >> 3);
        if (row < 67) { v4u val = (v4u){0u, 0u, 0u, 0u}; if (t0 - 3 + row >= 0) val = *(const GAS v4u*)(ri + (n0 + row - 3) * 512 + chb + 8 * (lane & 7));
            *(LAS v4u*)(Lw + row * ROWB + (lane & 7) * 16) = val; } }
    LAS float* cwl = (LAS float*)(Lw + CW_OFF);
#pragma unroll
    for (int tap = 0; tap < 4; ++tap) cwl[tap * 64 + lane] = cw[tap * 512 + chb + lane];
    cwl[256 + lane] = cb[chb + lane];
    bf16x8 bfa[8];
#pragma unroll
    for (int f = 0; f < 8; ++f) bfa[f] = *((const GAS bf16x8*)wlru + ((size_t)(wave * 8 + f)) * 64 + lane);
    float cba[2], cbx[2], clam[2];
#pragma unroll
    for (int nt = 0; nt < 2; ++nt) { const int gch = chb + 32 * nt + r32; cba[nt] = ba[gch]; cbx[nt] = bx[gch]; clam[nt] = lam[gch]; }
    asm volatile("s_waitcnt vmcnt(0) lgkmcnt(0)" ::: "memory");
    bf16x8 af[2][4];
#pragma unroll
    for (int ks = 0; ks < 4; ++ks) { const int cof = 16 * ks + 8 * hi;
        f32x4 w[4][2], bb[2];
#pragma unroll
        for (int tap = 0; tap < 4; ++tap) { w[tap][0] = *(const LAS f32x4*)(cwl + tap * 64 + cof); w[tap][1] = *(const LAS f32x4*)(cwl + tap * 64 + cof + 4); }
        bb[0] = *(const LAS f32x4*)(cwl + 256 + cof); bb[1] = *(const LAS f32x4*)(cwl + 256 + cof + 4);
#pragma unroll
        for (int mt = 0; mt < 2; ++mt) { const int tl = 32 * mt + r32;
            float a8[8];
#pragma unroll
            for (int e = 0; e < 8; ++e) a8[e] = bb[e >> 2][e & 3];
#pragma unroll
            for (int tap = 0; tap < 4; ++tap) { const v4u d = *(const LAS v4u*)(Lw + (tl + tap) * ROWB + cof * 2);
#pragma unroll
                for (int e = 0; e < 8; ++e) { const unsigned dw = d[e >> 1]; const float xv = __uint_as_float((e & 1) ? (dw & 0xffff0000u) : (dw << 16)); a8[e] += w[tap][e >> 2][e & 3] * xv; } }
            v4u pk; pk.x = pk2(a8[0], a8[1]); pk.y = pk2(a8[2], a8[3]); pk.z = pk2(a8[4], a8[5]); pk.w = pk2(a8[6], a8[7]);
            af[mt][ks] = __builtin_bit_cast(bf16x8, pk);
            asm volatile("s_waitcnt lgkmcnt(0)" ::: "memory");
            *(LAS v4u*)(Lw + tl * ROWB + cof * 2) = pk; }
    }
    f32x16 acc[2][2][2];
#pragma unroll
    for (int mat = 0; mat < 2; ++mat)
#pragma unroll
        for (int mt = 0; mt < 2; ++mt)
#pragma unroll
            for (int nt = 0; nt < 2; ++nt) acc[mat][mt][nt] = (f32x16){};
#pragma unroll
    for (int mat = 0; mat < 2; ++mat)
#pragma unroll
        for (int nt = 0; nt < 2; ++nt)
#pragma unroll
            for (int ks = 0; ks < 4; ++ks) { const bf16x8 bfr = (mat == 0) ? bfa[nt * 4 + ks] : *((const GAS bf16x8*)wlru + ((size_t)((mat * 8 + wave) * 8 + nt * 4 + ks)) * 64 + lane);
#pragma unroll
                for (int mt = 0; mt < 2; ++mt) acc[mat][mt][nt] = __builtin_amdgcn_mfma_f32_32x32x16_bf16(af[mt][ks], bfr, acc[mat][mt][nt], 0, 0, 0); }
    asm volatile("s_waitcnt lgkmcnt(0)" ::: "memory");
#pragma unroll
    for (int nt = 0; nt < 2; ++nt) { const int ch = 32 * nt + r32, gch = chb + ch;
        const float bav = cba[nt], bxv = cbx[nt]; const float nl = -clam[nt];
        const float k8 = -8.0f * 1.4426950408889634f * (fmaxf(nl, 0.f) + log1pf(expf(-fabsf(nl))));
#pragma unroll
        for (int mt = 0; mt < 2; ++mt)
#pragma unroll
            for (int r = 0; r < 16; ++r) { const int tl = 32 * mt + (r & 3) + 8 * (r >> 2) + 4 * hi;
                const float rec = bf2f(*(const LAS bf16_t*)(Lw + tl * ROWB + ch * 2));
                const float rg = fast_sigmoid(acc[0][mt][nt][r] + bav), ig = fast_sigmoid(acc[1][mt][nt][r] + bxv);
                const float a = __builtin_amdgcn_exp2f(k8 * rg);
                const float mult = __builtin_amdgcn_sqrtf(fmaxf(1.0f - a * a, 0.f));
                acc[0][mt][nt][r] = a; acc[1][mt][nt][r] = mult * ig * rec; }
        float gA[8], gH[8], pA[8], pH[8], myc[8], myp[8];
#pragma unroll
        for (int g = 0; g < 8; ++g) { const int mt = g >> 2, q4 = g & 3; float h = 0.f, p = 1.f;
#pragma unroll
            for (int i = 0; i < 4; ++i) { const float a = acc[0][mt][nt][4 * q4 + i]; h = a * h + acc[1][mt][nt][4 * q4 + i]; p *= a; }
            gA[g] = p; gH[g] = h; }
#pragma unroll
        for (int g = 0; g < 8; ++g) { pA[g] = __shfl_xor(gA[g], 32); pH[g] = __shfl_xor(gH[g], 32); }
        float cin = 0.f, pin = 1.f;
#pragma unroll
        for (int g = 0; g < 8; ++g) {
            const float A0 = hi ? pA[g] : gA[g], H0 = hi ? pH[g] : gH[g], A1 = hi ? gA[g] : pA[g], H1 = hi ? gH[g] : pH[g];
            const float cin1 = A0 * cin + H0, pin1 = A0 * pin;
            myc[g] = hi ? cin1 : cin; myp[g] = hi ? pin1 : pin;
            cin = A1 * cin1 + H1; pin = A1 * pin1; }
        if (hi == 0) { sumP[(size_t)item * 512 + gch] = pin; sumH[(size_t)item * 512 + gch] = cin; }
#pragma unroll
        for (int g = 0; g < 8; ++g) { const int mt = g >> 2, q4 = g & 3; float h = myc[g], p = myp[g];
#pragma unroll
            for (int i = 0; i < 4; ++i) { const int r = 4 * q4 + i; const float a = acc[0][mt][nt][r]; h = a * h + acc[1][mt][nt][r]; p = a * p; Hl[mt][nt][r] = h; Pc[mt][nt][r] = p; } }
    }
}
__device__ __forceinline__ void stage2(int item, int wave, int lane, LAS unsigned char* Lw, const bf16_t* gg, bf16_t* ao, const float* sumP, const float* sumH,
                                       const f32x16 (&Pc)[2][2], const f32x16 (&Hl)[2][2]) {
    const int b = item >> 6, c = item & 63, t0 = c * 64; const size_t n0 = (size_t)b * SEQ + t0;
    const int r32 = lane & 31, hi = lane >> 5, chb = wave * 64;
    float carry = 0.f;
    { const float* sp = sumP + (size_t)(b * 64) * 512 + chb + lane; const float* sh = sumH + (size_t)(b * 64) * 512 + chb + lane;
#pragma unroll 1
        for (int c0 = 0; c0 < c; c0 += 32) { float pv[32], hv[32];
#pragma unroll
            for (int i = 0; i < 32; ++i) { pv[i] = sp[(size_t)(c0 + i) * 512]; hv[i] = sh[(size_t)(c0 + i) * 512]; }
#pragma unroll
            for (int i = 0; i < 32; ++i) { const bool on = (c0 + i) < c; carry = on ? (pv[i] * carry + hv[i]) : carry; } } }
#pragma unroll
    for (int nt = 0; nt < 2; ++nt) { const int ch = 32 * nt + r32; const float cv = __shfl(carry, ch);
#pragma unroll
        for (int mt = 0; mt < 2; ++mt)
#pragma unroll
            for (int r = 0; r < 16; ++r) { const int tl = 32 * mt + (r & 3) + 8 * (r >> 2) + 4 * hi;
                *(LAS bf16_t*)(Lw + tl * ROWB + ch * 2) = f2bf(Hl[mt][nt][r] + Pc[mt][nt][r] * cv); } }
    asm volatile("s_waitcnt lgkmcnt(0)" ::: "memory");
#pragma unroll
    for (int pass = 0; pass < 8; ++pass) { const int row = pass * 8 + (lane >> 3), cof = 8 * (lane & 7);
        const v4u hv = *(const LAS v4u*)(Lw + row * ROWB + cof * 2); const v4u gv = *(const GAS v4u*)(gg + (n0 + row) * 512 + chb + cof);
        v4u o;
#pragma unroll
        for (int e = 0; e < 4; ++e) { const float h0 = __uint_as_float(hv[e] << 16), h1 = __uint_as_float(hv[e] & 0xffff0000u), g0 = __uint_as_float(gv[e] << 16), g1 = __uint_as_float(gv[e] & 0xffff0000u); o[e] = pk2(h0 * g0, h1 * g1); }
        *(GAS v4u*)(ao + (n0 + row) * 1024 + 512 + chb + cof) = o; }
    asm volatile("s_waitcnt lgkmcnt(0)" ::: "memory");
}
__device__ __forceinline__ void convert_item(int it, int lane, const float* wa, const float* wx, bf16_t* wlru) {
    const int mat = it >> 3, blk = it & 7, r32 = lane & 31, hi = lane >> 5; const float* W = (mat ? wx : wa) + (size_t)blk * 4096;
#pragma unroll
    for (int f = 0; f < 8; ++f) { const int nt = f >> 2, ks = f & 3; float v[8];
#pragma unroll
        for (int j = 0; j < 8; ++j) v[j] = W[(16 * ks + 8 * hi + j) * 64 + 32 * nt + r32];
        v4u o; o.x = pk2(v[0], v[1]); o.y = pk2(v[2], v[3]); o.z = pk2(v[4], v[5]); o.w = pk2(v[6], v[7]);
        *((GAS v4u*)wlru + ((size_t)(it * 8 + f)) * 64 + lane) = o; }
}
}
namespace moe {
constexpr int LCAP = 16384;
constexpr int AROW = 272, ABUF = 128 * AROW  , HROW = 528, META_OFF = 2 * ABUF  ;
typedef float f4_t __attribute__((ext_vector_type(4)));
__device__ __forceinline__ int crow(int r, int hi) { return (r & 3) + 8 * (r >> 2) + 4 * hi; }
__device__ __forceinline__ unsigned ld_u32_agent(const unsigned* p) { return __hip_atomic_load(p, __ATOMIC_RELAXED, __HIP_MEMORY_SCOPE_AGENT); }

typedef float f2_t __attribute__((ext_vector_type(2))); typedef __bf16 bf2_t __attribute__((ext_vector_type(2))); typedef unsigned long long u64;
constexpr float W1_SCALE = 64.0f, W2_SCALE = 32.0f;
__device__ __forceinline__ u64 pack_fp8x8(const float (&v)[8], float sc) {
    int lo = __builtin_amdgcn_cvt_pk_fp8_f32(v[0] * sc, v[1] * sc, 0, false); lo = __builtin_amdgcn_cvt_pk_fp8_f32(v[2] * sc, v[3] * sc, lo, true);
    int hi = __builtin_amdgcn_cvt_pk_fp8_f32(v[4] * sc, v[5] * sc, 0, false); hi = __builtin_amdgcn_cvt_pk_fp8_f32(v[6] * sc, v[7] * sc, hi, true);
    return (u64)(unsigned)lo | ((u64)(unsigned)hi << 32);
}
__device__ __forceinline__ bf16x8 fp8x8_to_bf16(unsigned lo_, unsigned hi_) {
    const int lo = (int)lo_, hi = (int)hi_;
    const f2_t a = __builtin_amdgcn_cvt_pk_f32_fp8(lo, false), b = __builtin_amdgcn_cvt_pk_f32_fp8(lo, true), c = __builtin_amdgcn_cvt_pk_f32_fp8(hi, false), d = __builtin_amdgcn_cvt_pk_f32_fp8(hi, true);
    v4u o; o.x = __builtin_bit_cast(unsigned, __builtin_convertvector(a, bf2_t)); o.y = __builtin_bit_cast(unsigned, __builtin_convertvector(b, bf2_t));
    o.z = __builtin_bit_cast(unsigned, __builtin_convertvector(c, bf2_t)); o.w = __builtin_bit_cast(unsigned, __builtin_convertvector(d, bf2_t));
    return __builtin_bit_cast(bf16x8, o);
}
__device__ __forceinline__ void pair8_from_kn(const float* W, int ldw, int ksp, int n0, GAS v4u* dst, int lane, const float* kgain, float sc) {
    const int r32 = lane & 31, hi = lane >> 5; float v[2][8];
#pragma unroll
    for (int h = 0; h < 2; ++h)
#pragma unroll
        for (int j = 0; j < 8; ++j) v[h][j] = W[(size_t)(32 * ksp + 16 * h + 8 * hi + j) * ldw + n0 + r32];
    if (kgain) {
#pragma unroll
        for (int h = 0; h < 2; ++h)
#pragma unroll
            for (int j = 0; j < 8; ++j) v[h][j] *= kgain[32 * ksp + 16 * h + 8 * hi + j]; }
    const u64 a = pack_fp8x8(v[0], sc), b = pack_fp8x8(v[1], sc);
    v4u o; o.x = (unsigned)a; o.y = (unsigned)(a >> 32); o.z = (unsigned)b; o.w = (unsigned)(b >> 32);
    dst[lane] = o;
}
__device__ __forceinline__ void frag_from_kn(const float* W, int ldw, int k0, int n0, GAS v4u* dst, int lane, const float* kgain) {
    const int r32 = lane & 31, hi = lane >> 5; float v[8];
#pragma unroll
    for (int j = 0; j < 8; ++j) v[j] = W[(size_t)(k0 + 8 * hi + j) * ldw + n0 + r32];
    if (kgain) {
#pragma unroll
        for (int j = 0; j < 8; ++j) v[j] *= kgain[k0 + 8 * hi + j]; }
    v4u o; o.x = pk2(v[0], v[1]); o.y = pk2(v[2], v[3]); o.z = pk2(v[4], v[5]); o.w = pk2(v[6], v[7]);
    dst[lane] = o;
}
constexpr int CONV_ITEMS = 4096 + 2048 + 128;
struct ConvP { const float* W; int ldw, ksp, n0; const float* gain; float sc; GAS v4u* dst; int dstride; };
__device__ __forceinline__ ConvP conv_decode(int it, const float* wgate, const float* wup, const float* wdown, const float* g2, bf16_t* w1f, bf16_t* w2f) {
    ConvP p;
    if (it < 4096) { const int e = it >> 7, gu = (it >> 6) & 1, fh = (it >> 5) & 1; p.ksp = it & 31; p.W = (gu ? wup : wgate) + (size_t)e * 1024 * 256; p.ldw = 256; p.n0 = 128 * fh; p.gain = g2; p.sc = W1_SCALE;
        p.dst = (GAS v4u*)w1f + ((size_t)((e * 16 + gu * 8 + 4 * fh) * 32 + p.ksp)) * 64; p.dstride = 32 * 64; }
    else { const int r = it - 4096, e = r >> 6, dq = r & 7; p.ksp = (r >> 3) & 7; p.W = wdown + (size_t)e * 256 * 1024; p.ldw = 1024; p.n0 = 128 * dq; p.gain = nullptr; p.sc = W2_SCALE;
        p.dst = (GAS v4u*)w2f + ((size_t)((e * 32 + 4 * dq) * 8 + p.ksp)) * 64; p.dstride = 8 * 64; }
    return p;
}
__device__ __forceinline__ void conv_load(const ConvP& p, int lane, f4_t (&v)[16]) {
    const int r32 = lane & 31, hi = lane >> 5;
#pragma unroll
    for (int i = 0; i < 16; ++i) v[i] = *(const GAS f4_t*)(p.W + (size_t)(32 * p.ksp + 2 * i + hi) * p.ldw + p.n0 + 4 * r32);
}
__device__ __forceinline__ void conv_finish(const ConvP& p, int lane, LAS unsigned* T, const f4_t (&v)[16]) {
    const int r32 = lane & 31, hi = lane >> 5;
#pragma unroll
    for (int i = 0; i < 16; ++i) { const float gk = p.gain ? p.gain[32 * p.ksp + 2 * i + hi] * p.sc : p.sc;
        int d = __builtin_amdgcn_cvt_pk_fp8_f32(v[i][0] * gk, v[i][1] * gk, 0, false); d = __builtin_amdgcn_cvt_pk_fp8_f32(v[i][2] * gk, v[i][3] * gk, d, true);
        T[(2 * i + hi) * 33 + r32] = (unsigned)d; }
    asm volatile("s_waitcnt lgkmcnt(0)" ::: "memory");
    const LAS unsigned char* Tb = (const LAS unsigned char*)T;
#pragma unroll
    for (int f = 0; f < 4; ++f) { unsigned w[4];
#pragma unroll
        for (int q = 0; q < 4; ++q) { const int rowb = 16 * (q >> 1) + 8 * hi + 4 * (q & 1); unsigned x = 0;
#pragma unroll
            for (int b = 0; b < 4; ++b) x |= (unsigned)Tb[(rowb + b) * 132 + 32 * f + r32] << (8 * b);
            w[q] = x; }
        p.dst[(size_t)f * p.dstride + lane] = (v4u){w[0], w[1], w[2], w[3]}; }
    asm volatile("s_waitcnt lgkmcnt(0)" ::: "memory");
}
__device__ __forceinline__ void convert_item(int it, int lane, LAS unsigned* T, const float* wgate, const float* wup, const float* wdown, const float* wgrp, const float* winner, const float* g2, bf16_t* w1f, bf16_t* w2f, bf16_t* wrf) {
    if (it < 6144) { const ConvP p = conv_decode(it, wgate, wup, wdown, g2, w1f, w2f); f4_t v[16]; conv_load(p, lane, v); conv_finish(p, lane, T, v);
    } else { const int r = it - 6144, nt = r >> 6, ks = r & 63, r32 = lane & 31, hi = lane >> 5, col = 32 * nt + r32; float v[8];
#pragma unroll
        for (int j = 0; j < 8; ++j) { const int k = 16 * ks + 8 * hi + j; float x = 0.f;
            if (col < 4) x = wgrp[k * 4 + col]; else if (col < 36) { const int g = (col - 4) >> 3, ee = (col - 4) & 7; x = winner[((size_t)g * 1024 + k) * 8 + ee]; }
            v[j] = x * g2[k]; }
        v4u o; o.x = pk2(v[0], v[1]); o.y = pk2(v[2], v[3]); o.z = pk2(v[4], v[5]); o.w = pk2(v[6], v[7]);
        ((GAS v4u*)wrf)[(size_t)r * 64 + lane] = o; }
}

__device__ __forceinline__ void route_block(int blk, int tid, int wave, int lane, LAS unsigned char* L, const bf16_t* xg, const bf16_t* wrf, const float* ssqp, const float* bg, const float* bi,
                                            unsigned* cnt, unsigned* lists, float* linv, float* lw) {
    const int r32 = lane & 31, hi = lane >> 5, tok0 = blk * 64;
    f32x16 acc[2][2];
#pragma unroll
    for (int mt = 0; mt < 2; ++mt)
#pragma unroll
        for (int nt = 0; nt < 2; ++nt) acc[mt][nt] = (f32x16){};
#pragma unroll
    for (int ksl = 0; ksl < 8; ++ksl) { const int ks = 8 * wave + ksl; bf16x8 a[2], bq[2];
#pragma unroll
        for (int mt = 0; mt < 2; ++mt) a[mt] = *(const GAS bf16x8*)(xg + (size_t)(tok0 + 32 * mt + r32) * 1024 + 16 * ks + 8 * hi);
#pragma unroll
        for (int nt = 0; nt < 2; ++nt) bq[nt] = *((const GAS bf16x8*)wrf + (size_t)(nt * 64 + ks) * 64 + lane);
#pragma unroll
        for (int mt = 0; mt < 2; ++mt)
#pragma unroll
            for (int nt = 0; nt < 2; ++nt) acc[mt][nt] = __builtin_amdgcn_mfma_f32_32x32x16_bf16(a[mt], bq[nt], acc[mt][nt], 0, 0, 0); }
    LAS float* slab = (LAS float*)L + wave * 64 * 40;
#pragma unroll
    for (int mt = 0; mt < 2; ++mt)
#pragma unroll
        for (int r = 0; r < 16; ++r) { const int tk = 32 * mt + crow(r, hi); slab[tk * 40 + r32] = acc[mt][0][r]; if (r32 < 4) slab[tk * 40 + 32 + r32] = acc[mt][1][r]; }
    LAS unsigned* lc = (LAS unsigned*)(L + 8 * 64 * 40 * 4);
    if (tid < 64) lc[tid] = 0u;
    __syncthreads();
    if (wave == 0) {
        const int tok = tok0 + lane; float lg[36];
#pragma unroll
        for (int j4 = 0; j4 < 9; ++j4) { f4_t s = (f4_t){0.f, 0.f, 0.f, 0.f};
#pragma unroll
            for (int w = 0; w < 8; ++w) s += *(const LAS f4_t*)((const LAS float*)L + (w * 64 + lane) * 40 + 4 * j4);
            lg[4 * j4] = s[0]; lg[4 * j4 + 1] = s[1]; lg[4 * j4 + 2] = s[2]; lg[4 * j4 + 3] = s[3]; }
        float ss = 0.f;
#pragma unroll
        for (int j = 0; j < 4; ++j) { const f4_t v = *(const GAS f4_t*)(ssqp + (size_t)tok * 16 + 4 * j); ss += (v[0] + v[1]) + (v[2] + v[3]); }
        const float inv = 1.0f / sqrtf(ss * (1.0f / 1024.0f) + 1e-6f);
        float gl[4];
#pragma unroll
        for (int g = 0; g < 4; ++g) gl[g] = lg[g] * inv + bg[g];
        int gi = 0; float gm = gl[0];
#pragma unroll
        for (int g = 1; g < 4; ++g) if (gl[g] > gm) { gm = gl[g]; gi = g; }
        float gs = 0.f;
#pragma unroll
        for (int g = 0; g < 4; ++g) gs += expf(gl[g] - gm);
        const float gw = 1.0f / gs;
        float il[8];
#pragma unroll
        for (int e = 0; e < 8; ++e) { float v = lg[4 + e]; float bb = bi[e];
#pragma unroll
            for (int g = 1; g < 4; ++g) { v = (gi == g) ? lg[4 + 8 * g + e] : v; bb = (gi == g) ? bi[8 * g + e] : bb; }
            il[e] = v * inv + bb; }
        int e1 = 0; float m1 = il[0];
#pragma unroll
        for (int e = 1; e < 8; ++e) if (il[e] > m1) { m1 = il[e]; e1 = e; }
        int e2 = 0; float m2 = -3.0e38f;
#pragma unroll
        for (int e = 0; e < 8; ++e) if (e != e1 && il[e] > m2) { m2 = il[e]; e2 = e; }
        const float p2 = expf(m2 - m1), w1 = 1.0f / (1.0f + p2), w2 = p2 / (1.0f + p2);
        const int ge1 = gi * 8 + e1, ge2 = gi * 8 + e2;
        const unsigned rk1 = __hip_atomic_fetch_add(&lc[ge1], 1u, __ATOMIC_RELAXED, __HIP_MEMORY_SCOPE_WORKGROUP);
        const unsigned rk2 = __hip_atomic_fetch_add(&lc[ge2], 1u, __ATOMIC_RELAXED, __HIP_MEMORY_SCOPE_WORKGROUP);
        asm volatile("s_waitcnt lgkmcnt(0)" ::: "memory");
        if (lane < 32) { const unsigned c = lc[lane]; unsigned base = 0u; if (c) base = __hip_atomic_fetch_add(cnt + lane, c, __ATOMIC_RELAXED, __HIP_MEMORY_SCOPE_AGENT); lc[32 + lane] = base; }
        asm volatile("s_waitcnt vmcnt(0) lgkmcnt(0)" ::: "memory");
        const unsigned p1 = lc[32 + ge1] + rk1, p2i = lc[32 + ge2] + rk2;
        lists[(size_t)ge1 * LCAP + p1] = (unsigned)tok * 2u; lists[(size_t)ge2 * LCAP + p2i] = (unsigned)tok * 2u + 1u;
        linv[(size_t)ge1 * LCAP + p1] = inv; linv[(size_t)ge2 * LCAP + p2i] = inv; lw[(size_t)ge1 * LCAP + p1] = gw * w1; lw[(size_t)ge2 * LCAP + p2i] = gw * w2;
    }
}

constexpr int YST_OFF = 71680, YROW = 144, YWAVE = 32 * YROW;
constexpr float Y_SCALE = 16.0f;
template <int NTC> __device__ __forceinline__ void moe_item(int e, int row_off, int R, int tid, int wave, int lane, LAS unsigned char* L, const bf16_t* xg, const bf16_t* w1f, const bf16_t* w2f,
                                         const unsigned* lists, const float* tokinv, const float* slotw, bf16_t* y) {
    lane = fresh_lane(); tid = wave * 64 + lane;
    const int r32 = lane & 31, hi = lane >> 5;
    constexpr int ntc = NTC;
    LAS unsigned* metaS = (LAS unsigned*)(L + META_OFF); LAS float* metaI = (LAS float*)(L + META_OFF + 512); LAS float* metaW = (LAS float*)(L + META_OFF + 1024);
    if (tid < 128) { const size_t li = (size_t)e * LCAP + row_off + (tid < R ? tid : 0); metaS[tid] = lists[li]; metaI[tid] = tokinv[li]; metaW[tid] = slotw[li]; }
    __syncthreads();
    const int srow = tid >> 4, c16 = tid & 15;
    v4u st[4];
#pragma unroll
    for (int p = 0; p < 4; ++p) st[p] = *(const GAS v4u*)(xg + (size_t)(metaS[srow + 32 * p] >> 1) * 1024 + c16 * 8);
#pragma unroll
    for (int p = 0; p < 4; ++p) *(LAS v4u*)(L + (srow + 32 * p) * AROW + c16 * 16) = st[p];
    f32x16 g[4], u[4];
#pragma unroll
    for (int nt = 0; nt < 4; ++nt) { g[nt] = (f32x16){}; u[nt] = (f32x16){}; }
    const GAS v4u* wgp = (const GAS v4u*)w1f + ((size_t)(e * 16 + wave) * 32) * 64 + lane;
    const GAS v4u* wup = (const GAS v4u*)w1f + ((size_t)(e * 16 + 8 + wave) * 32) * 64 + lane;
    v4u wgq[4], wuq[4];
#pragma unroll
    for (int s = 0; s < 4; ++s) { wgq[s] = wgp[s * 64]; wuq[s] = wup[s * 64]; }
    __syncthreads();
    bf16x8 tb[2][4];
    { const LAS unsigned char* ab = L + r32 * AROW + hi * 16;
#pragma unroll
        for (int nt = 0; nt < NTC; ++nt) tb[0][nt] = *(const LAS bf16x8*)(ab + nt * 32 * AROW); }
    for (int kc = 0; kc < 8; ++kc) {
        if (kc < 7) {
#pragma unroll
            for (int p = 0; p < 4; ++p) st[p] = *(const GAS v4u*)(xg + (size_t)(metaS[srow + 32 * p] >> 1) * 1024 + c16 * 8 + (kc + 1) * 128); }
        const LAS unsigned char* ab = L + (kc & 1) * ABUF + r32 * AROW + hi * 16;
#pragma unroll
        for (int ksl = 0; ksl < 8; ++ksl) { const int ks = kc * 8 + ksl, cur = ksl & 1; const v4u pg = wgq[ksl >> 1], pu = wuq[ksl >> 1];
            const bf16x8 wg = (ksl & 1) ? fp8x8_to_bf16(pg.z, pg.w) : fp8x8_to_bf16(pg.x, pg.y), wu = (ksl & 1) ? fp8x8_to_bf16(pu.z, pu.w) : fp8x8_to_bf16(pu.x, pu.y);
            if (ksl < 7) {
#pragma unroll
                for (int nt = 0; nt < NTC; ++nt) tb[cur ^ 1][nt] = *(const LAS bf16x8*)(ab + nt * 32 * AROW + (ksl + 1) * 32); }
            if ((ksl & 1) && (ks >> 1) + 4 < 32) { wgq[ksl >> 1] = wgp[(size_t)((ks >> 1) + 4) * 64]; wuq[ksl >> 1] = wup[(size_t)((ks >> 1) + 4) * 64]; }
#pragma unroll
            for (int nt = 0; nt < NTC; ++nt) {
                g[nt] = __builtin_amdgcn_mfma_f32_32x32x16_bf16(wg, tb[cur][nt], g[nt], 0, 0, 0); u[nt] = __builtin_amdgcn_mfma_f32_32x32x16_bf16(wu, tb[cur][nt], u[nt], 0, 0, 0); } }
        if (kc < 7) {
#pragma unroll
            for (int p = 0; p < 4; ++p) *(LAS v4u*)(L + ((kc + 1) & 1) * ABUF + (srow + 32 * p) * AROW + c16 * 16) = st[p]; }
        __syncthreads();
        if (kc < 7) { const LAS unsigned char* an = L + ((kc + 1) & 1) * ABUF + r32 * AROW + hi * 16;
#pragma unroll
            for (int nt = 0; nt < NTC; ++nt) tb[0][nt] = *(const LAS bf16x8*)(an + nt * 32 * AROW); }
    }
#pragma unroll
    for (int nt = 0; nt < NTC; ++nt) { const int tk = 32 * nt + r32; const float inv = metaI[tk] * (1.0f / W1_SCALE), wv = metaW[tk] * (1.0f / W2_SCALE);
#pragma unroll
        for (int q = 0; q < 4; ++q) { float h[4];
#pragma unroll
            for (int i = 0; i < 4; ++i) { const float gz = g[nt][4 * q + i] * inv, uz = u[nt][4 * q + i] * inv;
                h[i] = gz * __builtin_amdgcn_rcpf(1.0f + __builtin_amdgcn_exp2f(-1.4426950408889634f * gz)) * uz * wv; }
            const unsigned long long pk = (unsigned long long)pk2(h[0], h[1]) | ((unsigned long long)pk2(h[2], h[3]) << 32);
            *(LAS unsigned long long*)(L + tk * HROW + (32 * wave + 8 * q + 4 * hi) * 2) = pk; } }
    asm volatile("" ::: "memory");
    const int lane2 = fresh_lane();
    const GAS v4u* r0 = (const GAS v4u*)w2f + ((size_t)(e * 32 + 2 * wave) * 8) * 64 + lane2;
    const GAS v4u* r1 = r0 + 8 * 64;
    v4u q0[4], q1[4];
#pragma unroll
    for (int s = 0; s < 4; ++s) { q0[s] = *r0; q1[s] = *r1; r0 += 64; r1 += 64; }
    __syncthreads();
    LAS unsigned char* yst = L + YST_OFF + wave * YWAVE;
#pragma unroll 1
    for (int pass = 0; pass < 2; ++pass) { const int dtb = 16 * pass + 2 * wave;
        asm volatile("" ::: "memory");
        f32x16 ya[2][4];
#pragma unroll
        for (int d2 = 0; d2 < 2; ++d2)
#pragma unroll
            for (int nt = 0; nt < 4; ++nt) ya[d2][nt] = (f32x16){};
        const LAS unsigned char* hb = L + r32 * HROW + hi * 16;
#pragma unroll
        for (int nt = 0; nt < NTC; ++nt) tb[0][nt] = *(const LAS bf16x8*)(hb + nt * 32 * HROW);
#pragma unroll
        for (int ks = 0; ks < 16; ++ks) { const int cur = ks & 1; const v4u p0 = q0[(ks >> 1) & 3], p1 = q1[(ks >> 1) & 3];
            const bf16x8 a0 = (ks & 1) ? fp8x8_to_bf16(p0.z, p0.w) : fp8x8_to_bf16(p0.x, p0.y), a1 = (ks & 1) ? fp8x8_to_bf16(p1.z, p1.w) : fp8x8_to_bf16(p1.x, p1.y);
            if (ks < 15) {
#pragma unroll
                for (int nt = 0; nt < NTC; ++nt) tb[cur ^ 1][nt] = *(const LAS bf16x8*)(hb + nt * 32 * HROW + (ks + 1) * 32); }
            if (ks & 1) { const int ksp = ks >> 1;
                if (ksp == 4 && pass == 0) { r0 += 120 * 64; r1 += 120 * 64; }
                if (ksp < 4 || pass == 0) { q0[ksp & 3] = *r0; q1[ksp & 3] = *r1; r0 += 64; r1 += 64; } }
#pragma unroll
            for (int nt = 0; nt < NTC; ++nt) {
                ya[0][nt] = __builtin_amdgcn_mfma_f32_32x32x16_bf16(a0, tb[cur][nt], ya[0][nt], 0, 0, 0); ya[1][nt] = __builtin_amdgcn_mfma_f32_32x32x16_bf16(a1, tb[cur][nt], ya[1][nt], 0, 0, 0); } }
        const int lane3 = fresh_lane();
#pragma unroll
        for (int nt = 0; nt < NTC; ++nt) {
#pragma unroll
            for (int d2 = 0; d2 < 2; ++d2)
#pragma unroll
                for (int q = 0; q < 4; ++q) { int d = __builtin_amdgcn_cvt_pk_fp8_f32(ya[d2][nt][4 * q] * Y_SCALE, ya[d2][nt][4 * q + 1] * Y_SCALE, 0, false);
                    d = __builtin_amdgcn_cvt_pk_fp8_f32(ya[d2][nt][4 * q + 2] * Y_SCALE, ya[d2][nt][4 * q + 3] * Y_SCALE, d, true);
                    *(LAS unsigned*)(yst + r32 * 80 + 32 * d2 + 8 * q + 4 * hi) = (unsigned)d; }
            asm volatile("s_waitcnt lgkmcnt(0)" ::: "memory");
#pragma unroll
            for (int p = 0; p < 2; ++p) { const int row = p * 16 + (lane3 >> 2), ch = lane3 & 3, tk = 32 * nt + row; const v4u v = *(const LAS v4u*)(yst + row * 80 + ch * 16);
                if (tk < R) *(GAS v4u*)((unsigned char*)y + (size_t)metaS[tk] * 1024 + 32 * dtb + ch * 16) = v; }
            asm volatile("s_waitcnt lgkmcnt(0)" ::: "memory"); }
    }
    __syncthreads();
}
__device__ __forceinline__ void moe_phase(int vcu, int G, int tid, int wave, int lane, LAS unsigned char* L, const bf16_t* xg, const bf16_t* w1f, const bf16_t* w2f,
                                          const unsigned* cnt, const unsigned* lists, const float* tokinv, const float* slotw, bf16_t* y) {
    LAS int* sc = (LAS int*)(L + YST_OFF + 8 * YWAVE);
    if (tid < 32) sc[tid] = (int)ld_u32_agent(cnt + tid);
    __syncthreads();
    if (tid < 32) { const int c = sc[tid], r = c & 127; int pf = 0, rk = 0, F = 0, NR = 0;
        for (int k = 0; k < 32; ++k) { const int ck = sc[k], rk_ = ck & 127; if (k < tid) pf += ck >> 7; F += ck >> 7; NR += rk_ > 0; if (rk_ > r || (rk_ == r && k < tid)) rk += 1; }
        sc[32 + tid] = pf; sc[64 + tid] = r > 0 ? rk : 9999; if (tid == 0) { sc[96] = F; sc[97] = NR; } }
    __syncthreads();
    const int F = sc[96], M = F + sc[97];
    for (int r = 0;; ++r) {
        const int i = r * G + ((r & 1) ? (G - 1 - vcu) : vcu);
        if (i >= M) break;
        int e = 0, row_off = 0, R = 128;
        if (i < F) { for (int k = 1; k < 32; ++k) if (sc[32 + k] <= i) e = k; row_off = (i - sc[32 + e]) * 128; }
        else { const int rk = i - F; for (int k = 0; k < 32; ++k) if (sc[64 + k] == rk) e = k; row_off = (sc[e] >> 7) * 128; R = sc[e] & 127; }
        e = __builtin_amdgcn_readfirstlane(e); row_off = __builtin_amdgcn_readfirstlane(row_off); R = __builtin_amdgcn_readfirstlane(R);
        if (R > 96) moe_item<4>(e, row_off, R, tid, wave, lane, L, xg, w1f, w2f, lists, tokinv, slotw, y);
        else if (R > 64) moe_item<3>(e, row_off, R, tid, wave, lane, L, xg, w1f, w2f, lists, tokinv, slotw, y);
        else if (R > 32) moe_item<2>(e, row_off, R, tid, wave, lane, L, xg, w1f, w2f, lists, tokinv, slotw, y);
        else moe_item<1>(e, row_off, R, tid, wave, lane, L, xg, w1f, w2f, lists, tokinv, slotw, y);
    }
}
__device__ __forceinline__ void unpack4(unsigned long long a, float (&f)[4]) {
    f[0] = __uint_as_float((unsigned)a << 16); f[1] = __uint_as_float((unsigned)a & 0xffff0000u); f[2] = __uint_as_float((unsigned)(a >> 32) << 16); f[3] = __uint_as_float((unsigned)(a >> 32) & 0xffff0000u); }
template <int NR> __device__ __forceinline__ void final_rows(int m, int lane, const bf16_t* x1, const bf16_t* y, const float* fn, float* out) {
    typedef unsigned long long u64;
    u64 xa[NR][4]; unsigned ya[NR][4], yb[NR][4];
#pragma unroll
    for (int r = 0; r < NR; ++r) { const GAS u64* xr = (const GAS u64*)(x1 + (size_t)(m + r) * 1024) + lane; const GAS unsigned* y0 = (const GAS unsigned*)((const unsigned char*)y + (size_t)(2 * (m + r)) * 1024) + lane;
#pragma unroll
        for (int j = 0; j < 4; ++j) { xa[r][j] = xr[64 * j]; ya[r][j] = y0[64 * j]; yb[r][j] = y0[256 + 64 * j]; } }
    const GAS f4_t* gr = (const GAS f4_t*)fn + lane; f4_t gg[4];
#pragma unroll
    for (int j = 0; j < 4; ++j) gg[j] = gr[64 * j];
#pragma unroll
    for (int r = 0; r < NR; ++r) { f4_t v[4]; float s = 0.f;
#pragma unroll
        for (int j = 0; j < 4; ++j) { float a[4]; unpack4(xa[r][j], a);
            const f2_t b0 = __builtin_amdgcn_cvt_pk_f32_fp8((int)ya[r][j], false), b1 = __builtin_amdgcn_cvt_pk_f32_fp8((int)ya[r][j], true), c0 = __builtin_amdgcn_cvt_pk_f32_fp8((int)yb[r][j], false), c1 = __builtin_amdgcn_cvt_pk_f32_fp8((int)yb[r][j], true);
            v[j][0] = a[0] + (b0[0] + c0[0]) * (1.0f / Y_SCALE); v[j][1] = a[1] + (b0[1] + c0[1]) * (1.0f / Y_SCALE); v[j][2] = a[2] + (b1[0] + c1[0]) * (1.0f / Y_SCALE); v[j][3] = a[3] + (b1[1] + c1[1]) * (1.0f / Y_SCALE);
#pragma unroll
            for (int i = 0; i < 4; ++i) s += v[j][i] * v[j][i]; }
        const float inv = 1.0f / sqrtf(wave_sum(s) * (1.0f / 1024.0f) + 1e-6f);
        GAS f4_t* o = (GAS f4_t*)(out + (size_t)(m + r) * 1024) + lane;
#pragma unroll
        for (int j = 0; j < 4; ++j) o[64 * j] = v[j] * inv * gg[j]; }
}
}
struct Args { const float* in[21]; float* out; unsigned char* ws; int ph_lo, ph_hi, li, pad; };
__global__ void __launch_bounds__(512, 2) mega(Args args) {
    extern __shared__ __attribute__((aligned(16))) unsigned char lds[];
    const int tid = threadIdx.x, lane = tid & 63, wave = __builtin_amdgcn_readfirstlane(tid >> 6);
    const int G = gridDim.x, bx = blockIdx.x, vcu = (G % 8 == 0) ? (bx % 8) * (G / 8) + bx / 8 : bx;
    LAS unsigned char* L = (LAS unsigned char*)lds;
    for (int u = tid; u < (LDS_BYTES - LDSCTL_OFF) / 4; u += 512) ((LAS unsigned*)(L + LDSCTL_OFF))[u] = 0u;
    __syncthreads();
    unsigned char* ws = args.ws;
    unsigned* ctl = (unsigned*)(ws + WS_CTL);
    XcdBarrier bar = xcd_barrier_post(ctl + CW_BAR + args.li * XCD_BAR_WORDS, (volatile LAS unsigned*)(L + MISC_OFF) + 8);
    const int lo = args.ph_lo, hi = args.ph_hi;
#define IN(k) (lo <= (k) && (k) < hi)
#define BOTH(k) (IN(k) && IN((k) + 1))
    const float* x = args.in[0];
    bf16_t* Wt_in = (bf16_t*)(ws + WS_WIN); bf16_t* Wt_out = (bf16_t*)(ws + WS_WOUT);
    bf16_t* hn = (bf16_t*)(ws + WS_X1 + 32 * MiB);
    float* rowinv = (float*)(ws + WS_RT + 320 * 1024);
    const int gw = vcu * 8 + wave, NGW = G * 8;

    if (IN(0)) {
        LAS float* scr = (LAS float*)(L + wave * 16384);
        constexpr int I_IN = 88 * 16, I_OUT = 32 * 16;
        for (int it = gw; it < I_IN + I_OUT; it += NGW) {
            if (it < I_IN) { const int kb = it / 88, nb = it % 88, n0 = nb * 32;
                int src = n0, nv = 32; if (n0 >= 1536 && n0 < 2560) src = n0 + 8; else if (n0 == 2560) { src = 1536; nv = 8; } else if (n0 > 2560) { src = 0; nv = 0; }
                p0_transpose_item(args.in[2], DM, INC, src, nv, Wt_in, n0, kb * 64, scr, lane, args.in[1]); }
            else { const int r = it - I_IN, kb = r / 32, nb = r % 32;
                p0_transpose_item(args.in[11], DM, DM, nb * 32, 32, Wt_out, nb * 32, kb * 64, scr, lane, nullptr); }
        }
        for (int it = 6144 + gw; it < moe::CONV_ITEMS; it += NGW) moe::convert_item(it, lane, (LAS unsigned*)(L + 84480 + wave * 4352), args.in[17], args.in[18], args.in[19], args.in[13], args.in[15], args.in[12], (bf16_t*)(ws + WS_W1F), (bf16_t*)(ws + WS_W2F), (bf16_t*)(ws + WS_WR));
        for (int it = gw; it < 16; it += NGW) lru::convert_item(it, lane, args.in[6], args.in[8], (bf16_t*)(ws + WS_WLRU));
        for (int m = gw; m < NTOK; m += NGW) row_to_bf16_inv(x + (size_t)m * DM, hn + (size_t)m * DM, rowinv + m, lane);
        if (BOTH(0)) xcd_barrier(bar);
    }
    if (IN(1)) {
        pg8::Gemm g{hn, Wt_in, NTOK, NIN, DM}; pg8::StaticOrder S; S.init(NTOK, NIN, G, bx);
        pg8::EpiInProj E{(bf16_t*)(ws + WS_Q), (bf16_t*)(ws + WS_K), (bf16_t*)(ws + WS_V), (bf16_t*)(ws + WS_GG), (bf16_t*)(ws + WS_RI), (float*)(ws + WS_LF), args.in[3], rowinv};
        pg8::gemm_phase<pg8::EpiInProj, pg8::StaticOrder, true, true>(L, g, S, E);
        if (BOTH(1)) xcd_barrier(bar);
    }
    if (IN(2)) { const int lane = fresh_lane();
        f32x16 Pc[2][2], Hl[2][2];
        LAS unsigned char* Lw = L + wave * lru::WAVE_LDS;
        float* sumP = (float*)(ws + WS_SUM); float* sumH = sumP + 256 * 512;
        const bool act = bx < 256;
        if (act) lru::stage1(bx, wave, lane, Lw, (const bf16_t*)(ws + WS_RI), (const bf16_t*)(ws + WS_WLRU), args.in[4], args.in[5], args.in[7], args.in[9], args.in[10], sumP, sumH, Pc, Hl);
        xcd_barrier(bar);
        if (act) lru::stage2(bx, wave, lane, Lw, (const bf16_t*)(ws + WS_GG), (bf16_t*)(ws + WS_AO), sumP, sumH, Pc, Hl);
        __syncthreads();
    }
    if (IN(3)) {
        static_assert(attn_body::ATTN_LDS_BYTES <= LDSCTL_OFF, "attention LDS");
        const attn_body::AttnTensors AT{(const attn_body::bf16*)(ws + WS_Q), (const attn_body::bf16*)(ws + WS_K), (const attn_body::bf16*)(ws + WS_V), (attn_body::bf16*)(ws + WS_AO), (const float*)(ws + WS_LF)};
        const attn_body::StaticOrder S(G, bx);
        attn_body::attn_phase<attn_body::StaticOrder, 80>((char*)lds, AT, S);
        if (BOTH(3)) xcd_barrier(bar);
    }
    if (IN(4)) {
        pg8::Gemm g{(const bf16_t*)(ws + WS_AO), Wt_out, NTOK, DM, DM}; pg8::StaticOrder S; S.init(NTOK, DM, G, bx);
        pg8::EpiOutProj E{hn, (bf16_t*)(ws + WS_X1), (float*)(ws + WS_SSQP)};
        pg8::gemm_phase<pg8::EpiOutProj, pg8::StaticOrder, false, true>(L, g, S, E);
        if (BOTH(4)) xcd_barrier(bar);
    }
    unsigned* ecnt = ctl + CW_CNT; unsigned* lists = (unsigned*)(ws + WS_LIST); float* tokinv = (float*)(ws + 170 * MiB); float* slotw = (float*)(ws + 172 * MiB);
    if (IN(5)) { const int lane = fresh_lane(), tid = wave * 64 + lane;
        for (int blk = bx; blk < NTOK / 64; blk += G) { if (blk != bx) __syncthreads();
            moe::route_block(blk, tid, wave, lane, L, (const bf16_t*)(ws + WS_X1), (const bf16_t*)(ws + WS_WR), (const float*)(ws + WS_SSQP), args.in[14], args.in[16], ecnt, lists, tokinv, slotw); }
        if (G != 256) { for (int it = gw; it < 6144; it += NGW) moe::convert_item(it, lane, (LAS unsigned*)(L + 84480 + wave * 4352), args.in[17], args.in[18], args.in[19], args.in[13], args.in[15], args.in[12], (bf16_t*)(ws + WS_W1F), (bf16_t*)(ws + WS_W2F), (bf16_t*)(ws + WS_WR)); }
        else { const int e = vcu >> 3, sub = (vcu & 7) * 8 + wave;
            LAS unsigned* T = (LAS unsigned*)(L + 84480 + wave * 4352);
            const int w1it = e * 128 + (sub >> 5) * 64 + (sub & 31);
            const moe::ConvP p0 = moe::conv_decode(w1it, args.in[17], args.in[18], args.in[19], args.in[12], (bf16_t*)(ws + WS_W1F), (bf16_t*)(ws + WS_W2F));
            const moe::ConvP p1 = moe::conv_decode(w1it + 32, args.in[17], args.in[18], args.in[19], args.in[12], (bf16_t*)(ws + WS_W1F), (bf16_t*)(ws + WS_W2F));
            const moe::ConvP p2 = moe::conv_decode(4096 + e * 64 + sub, args.in[17], args.in[18], args.in[19], args.in[12], (bf16_t*)(ws + WS_W1F), (bf16_t*)(ws + WS_W2F));
            moe::f4_t va[16], vb[16];
            moe::conv_load(p0, lane, va); moe::conv_load(p1, lane, vb);
            moe::conv_finish(p0, lane, T, va); moe::conv_load(p2, lane, va);
            moe::conv_finish(p1, lane, T, vb); moe::conv_finish(p2, lane, T, va); }
        if (BOTH(5)) xcd_barrier(bar);
    }
    if (IN(6)) { const int lane = fresh_lane(), tid = wave * 64 + lane;
        moe::moe_phase(vcu, G, tid, wave, lane, L, (const bf16_t*)(ws + WS_X1), (const bf16_t*)(ws + WS_W1F), (const bf16_t*)(ws + WS_W2F), ecnt, lists, tokinv, slotw, (bf16_t*)(ws + WS_Y));
        if (BOTH(6)) xcd_barrier(bar);
    }
    if (IN(7)) { const int lane = fresh_lane();
        for (int m = gw * 8; m < NTOK; m += NGW * 8) moe::final_rows<8>(m, lane, (const bf16_t*)(ws + WS_X1), (const bf16_t*)(ws + WS_Y), args.in[20], args.out);
    }
#undef IN
#undef BOTH
}
#ifndef PROBE_K
#define PROBE_K -1
#endif
#ifndef PROBE_FLAGS
#define PROBE_FLAGS 0
#endif
extern "C" void kernel_launch(void* const* d_in, const int* in_sizes, int n_in, void* d_out, int out_size, void* d_ws, size_t ws_size, hipStream_t stream) {
    static int grid = 0;
    if (grid == 0) {
        if (n_in != 21 || ws_size < WS_END) { fprintf(stderr, "kernel_launch: unexpected n_in %d / ws %zu\n", n_in, ws_size); grid = -1; return; }
        int dev = 0, cus = 0;
        if (hipGetDevice(&dev) != hipSuccess || hipDeviceGetAttribute(&cus, hipDeviceAttributeMultiprocessorCount, dev) != hipSuccess) { grid = -1; return; }
        if (hipFuncSetAttribute((const void*)mega, hipFuncAttributeMaxDynamicSharedMemorySize, LDS_BYTES) != hipSuccess) { grid = -1; return; }
        grid = cus;
    }
    if (grid < 0) return;
    (void)hipMemsetAsync((char*)d_ws + WS_CTL, 0, CTL_ZERO_BYTES, stream);
    Args a{};
    for (int i = 0; i < 21; ++i) a.in[i] = (const float*)d_in[i];
    a.out = (float*)d_out; a.ws = (unsigned char*)d_ws;
    unsigned char* ws = (unsigned char*)d_ws;
    if (PROBE_K >= 0) {
        a.ph_lo = 0; a.ph_hi = PROBE_K + 1; a.li = 0; a.pad = PROBE_FLAGS;
        hipLaunchKernelGGL(mega, dim3(grid), dim3(512), LDS_BYTES, stream, a);
        (void)hipMemsetAsync((char*)d_ws + WS_CTL, 0, CTL_ZERO_BYTES, stream);
    }
    a.ph_lo = 0; a.ph_hi = 8; a.li = 0; a.pad = 0;
    hipLaunchKernelGGL(mega, dim3(grid), dim3(512), LDS_BYTES, stream, a);
}
```

```cpp
#include <hip/hip_runtime.h>
#include <hip/hip_bf16.h>
#include <cstdio>
#include <cstdint>
#include <cmath>
namespace pg8 {
#define PG8_LAS __attribute__((address_space(3)))
typedef unsigned short bf16_t;
typedef short bf16x8 __attribute__((ext_vector_type(8)));
typedef float f32x4 __attribute__((ext_vector_type(4)));
typedef unsigned u32x4 __attribute__((ext_vector_type(4)));
constexpr int BM = 256, BK = 64, HALF = 128, HTB = HALF * BK * 2  , STAGE_BYTES = 8 * HTB, NXCD = 8, WGM = 8;

__host__ __device__ __forceinline__ int lds_byte(int r, int c) { const int st = (r >> 4) * 2 + (c >> 5), rr = r & 15, cc = c & 31, ob = rr * 64 + cc * 2; return st * 1024 + (ob ^ (((ob >> 9) & 1) << 5)); }
__host__ __device__ __forceinline__ void stage_rc(int b, int& R, int& C) { const int st = b / 1024, sb = b % 1024, swz = sb ^ (((sb >> 9) & 1) << 5); R = (st >> 1) * 16 + swz / 64; C = (st & 1) * 32 + (swz % 64) / 2; }
__host__ __device__ __forceinline__ int perm32(int rho) { const int n = rho >> 4, i = rho & 15; return 8 * (i >> 2) + 4 * n + (i & 3); }

struct Unit { int pm, pn; };
struct Gemm { const bf16_t* A; const bf16_t* Bt; int M, N, K; };

struct StaticOrder {
    int nM, nN, nwg, G, c;
    __host__ __device__ void init(int M, int N, int G_, int c_) { nM = M / BM; nN = N / BM; nwg = nM * nN; G = G_; c = c_; }
    __host__ __device__ bool next(int i, Unit& u) const {
        const long L = (long)i * G + c; if (L >= nwg) return false;
        int wgid = (int)L; { const int q = nwg / NXCD, r = nwg % NXCD, xcd = wgid % NXCD, off = wgid / NXCD; wgid = (xcd < r ? xcd * (q + 1) : r * (q + 1) + (xcd - r) * q) + off; }
        const int nig = WGM * nN, gid = wgid / nig, fm = gid * WGM, gsz = (nM - fm) < WGM ? (nM - fm) : WGM;
        u.pm = fm + ((wgid % nig) % gsz); u.pn = (wgid % nig) / gsz; return true;
    }
    __device__ __forceinline__ void a_ready(const Unit&) const {}
    __device__ __forceinline__ void done(const Unit&) const {}
};

__device__ __forceinline__ unsigned cvt_pk_bf16(float lo, float hi) { unsigned r; asm volatile("v_cvt_pk_bf16_f32 %0, %1, %2" : "=v"(r) : "v"(lo), "v"(hi)); return r; }
__device__ __forceinline__ float gelu_fast(float x) {
    const float t = x * (1.5957691216057308f + 0.07135481627260025f * x * x);
    return x * __builtin_amdgcn_rcpf(1.0f + __builtin_amdgcn_exp2f(-1.4426950408889634f * t));
}
struct EpiInProj {
    static constexpr bool PERM = true, AFTER_DRAIN = false;
    bf16_t *q, *k, *v, *gg, *ri; float* lf; const float* bfg; const float* rinv;
    __device__ __forceinline__ void operator()(const f32x4 (&acc)[2][2][4][2], const Unit& u, int wr, int wc, int fr, int fq) const {
        const int seg = u.pn >> 1;
        const int row0 = u.pm * BM + wr * 64 + fr;
        if (seg < 5) {
            bf16_t* base = seg == 0 ? q : seg == 1 ? k : seg == 2 ? v : seg == 3 ? gg : ri;
            const int col0 = (u.pn & 1) * 256 + wc * 32 + 8 * fq;
#pragma unroll
            for (int ai = 0; ai < 2; ++ai)
#pragma unroll
                for (int m = 0; m < 4; ++m) { bf16_t* rowp = base + (size_t)(row0 + ai * HALF + m * 16) * 512 + col0; const float rv = rinv[row0 + ai * HALF + m * 16] * (seg == 0 ? 0.18033688011112042f : 1.0f);
#pragma unroll
                    for (int bj = 0; bj < 2; ++bj) { f32x4 v0 = acc[ai][bj][m][0] * rv, v1 = acc[ai][bj][m][1] * rv;
                        if (seg == 3) { v0 = (f32x4){gelu_fast(v0[0]), gelu_fast(v0[1]), gelu_fast(v0[2]), gelu_fast(v0[3])}; v1 = (f32x4){gelu_fast(v1[0]), gelu_fast(v1[1]), gelu_fast(v1[2]), gelu_fast(v1[3])}; }
                        u32x4 w; w.x = cvt_pk_bf16(v0[0], v0[1]); w.y = cvt_pk_bf16(v0[2], v0[3]); w.z = cvt_pk_bf16(v1[0], v1[1]); w.w = cvt_pk_bf16(v1[2], v1[3]);
                        *(u32x4*)(rowp + bj * HALF) = w; } }
        } else if (wc == 0) {
            if (fq == 0) {
#pragma unroll
                for (int ai = 0; ai < 2; ++ai)
#pragma unroll
                    for (int m = 0; m < 4; ++m) { const int row = row0 + ai * HALF + m * 16; const int b = row >> 12, s = row & 4095;
#pragma unroll
                        for (int n = 0; n < 2; ++n)
#pragma unroll
                            for (int j = 0; j < 4; ++j) { const int h = 4 * n + j; const float z = acc[ai][0][m][n][j] * rinv[row] + bfg[h];
                                lf[((size_t)(b * 8 + h) << 12) + s] = fminf(z, 0.f) - 0.6931471805599453f * __builtin_amdgcn_logf(1.0f + __builtin_amdgcn_exp2f(-1.4426950408889634f * fabsf(z))); } }
            }
        }
    }
};
struct EpiOutProj {
    static constexpr bool PERM = true, AFTER_DRAIN = false;
    const bf16_t* x; bf16_t* x1; float* ssqp;
    __device__ __forceinline__ void operator()(const f32x4 (&acc)[2][2][4][2], const Unit& u, int wr, int wc, int fr, int fq) const {
        const int row0 = u.pm * BM + wr * 64 + fr, col0 = u.pn * BM + wc * 32 + 8 * fq;
#pragma unroll
        for (int ai = 0; ai < 2; ++ai)
#pragma unroll
            for (int m = 0; m < 4; ++m) { const int row = row0 + ai * HALF + m * 16; const size_t off = (size_t)row * 1024 + col0; float s = 0.f;
#pragma unroll
                for (int bj = 0; bj < 2; ++bj) { const u32x4 xw = *(const u32x4*)(x + off + bj * HALF);
                    const f32x4 xa = (f32x4){__uint_as_float(xw.x << 16), __uint_as_float(xw.x & 0xffff0000u), __uint_as_float(xw.y << 16), __uint_as_float(xw.y & 0xffff0000u)};
                    const f32x4 xb = (f32x4){__uint_as_float(xw.z << 16), __uint_as_float(xw.z & 0xffff0000u), __uint_as_float(xw.w << 16), __uint_as_float(xw.w & 0xffff0000u)};
                    const f32x4 o0 = xa + acc[ai][bj][m][0], o1 = xb + acc[ai][bj][m][1];
                    u32x4 w; w.x = cvt_pk_bf16(o0[0], o0[1]); w.y = cvt_pk_bf16(o0[2], o0[3]); w.z = cvt_pk_bf16(o1[0], o1[1]); w.w = cvt_pk_bf16(o1[2], o1[3]);
                    *(u32x4*)(x1 + off + bj * HALF) = w;
                    s += ((o0[0] * o0[0] + o0[1] * o0[1]) + (o0[2] * o0[2] + o0[3] * o0[3])) + ((o1[0] * o1[0] + o1[1] * o1[1]) + (o1[2] * o1[2] + o1[3] * o1[3])); }
                s += __shfl_xor(s, 16); s += __shfl_xor(s, 32);
                if (fq == 0) ssqp[(size_t)row * 16 + u.pn * 4 + wc] = s;
                if (m & 1) asm volatile("" ::: "memory"); }
    }
};
template <class Epi, class Sched, bool ALIGN_EPI = false, bool SP2 = false>
__device__ __forceinline__ void gemm_phase(PG8_LAS unsigned char* lds, const Gemm g, const Sched& S, const Epi& E) {
    const int tid = threadIdx.x, wid = __builtin_amdgcn_readfirstlane(tid >> 6), lane = tid & 63, wr = wid >> 2, wc = wid & 3, fr = lane & 15, fq = lane >> 4;
    const int K = g.K, nt = K / BK;
    unsigned voffA[2], voffB[2];
#pragma unroll
    for (int i = 0; i < 2; ++i) { int R, C; stage_rc(tid * 16 + i * 8192, R, C); const int Rb = Epi::PERM ? ((R & ~31) + perm32(R & 31)) : R;
        voffA[i] = (unsigned)(R * K + C) * 2u; voffB[i] = (unsigned)(Rb * K + C) * 2u; }
    const size_t kstep = (size_t)(BK * 2);
    const size_t hstep = (size_t)HALF * K * 2;
    const size_t tstep = 2 * hstep;
    const unsigned ldsw = (unsigned)wid * 1024u;
    const int aoff = lds_byte(wr * 64 + fr, fq * 8), boff = lds_byte(wc * 32 + fr, fq * 8);
#define PG8_SA(b, h) (((b) * 2 + (h)) * HTB)
#define PG8_SB(b, h) ((4 + (b) * 2 + (h)) * HTB)
#define PG8_STAGE(bufoff, gbase, voff) do { _Pragma("unroll") for (int _i = 0; _i < 2; ++_i) \
        __builtin_amdgcn_global_load_lds((const unsigned*)((const char*)(gbase) + (voff)[_i]), (PG8_LAS unsigned*)(lds + (bufoff) + ldsw + _i * 8192), 16, 0, 0); } while (0)
#define PG8_LDA(dst, b, h) do { _Pragma("unroll") for (int m = 0; m < 4; ++m) _Pragma("unroll") for (int k = 0; k < 2; ++k) dst[m][k] = *(const PG8_LAS bf16x8*)(lds + PG8_SA(b, h) + aoff + m * 2048 + k * 1024); } while (0)
#define PG8_LDB(dst, b, h) do { _Pragma("unroll") for (int n = 0; n < 2; ++n) _Pragma("unroll") for (int k = 0; k < 2; ++k) dst[n][k] = *(const PG8_LAS bf16x8*)(lds + PG8_SB(b, h) + boff + n * 2048 + k * 1024); } while (0)
#define PG8_MMA(ai, bj, At, Bt) do { __builtin_amdgcn_s_setprio(1); _Pragma("unroll") for (int m = 0; m < 4; ++m) _Pragma("unroll") for (int n = 0; n < 2; ++n) _Pragma("unroll") for (int k = 0; k < 2; ++k) \
        acc[ai][bj][m][n] = __builtin_amdgcn_mfma_f32_16x16x32_bf16(Bt[n][k], At[m][k], acc[ai][bj][m][n], 0, 0, 0); __builtin_amdgcn_s_setprio(0); } while (0)
#define PG8_WAIT_V(n) asm volatile("s_waitcnt vmcnt(" #n ")" ::: "memory")
#define PG8_WAIT_L(n) asm volatile("s_waitcnt lgkmcnt(" #n ")" ::: "memory")
#define PG8_BAR __builtin_amdgcn_s_barrier()
#define PG8_SCHED __builtin_amdgcn_sched_barrier(0)
    Unit cur, nxt; int ui = 0;
    if (!S.next(0, cur)) return;
    f32x4 acc[2][2][4][2];
#pragma unroll
    for (int a = 0; a < 2; ++a)
#pragma unroll
        for (int b = 0; b < 2; ++b)
#pragma unroll
            for (int m = 0; m < 4; ++m)
#pragma unroll
                for (int n = 0; n < 2; ++n) acc[a][b][m][n] = (f32x4){0.f, 0.f, 0.f, 0.f};
    bf16x8 At[4][2], B0[2][2], B1[2][2];
    const char* cA = (const char*)g.A + (size_t)cur.pm * tstep; const char* cB = (const char*)g.Bt + (size_t)cur.pn * tstep;
    S.a_ready(cur);
    if constexpr (SP2) {
        PG8_STAGE(PG8_SB(0, 0), cB, voffB); PG8_STAGE(PG8_SB(0, 1), cB + hstep, voffB); PG8_STAGE(PG8_SA(0, 0), cA, voffA); PG8_STAGE(PG8_SA(0, 1), cA + hstep, voffA);
        if (wr == 1) PG8_BAR;
        PG8_WAIT_V(2); PG8_BAR;
        PG8_STAGE(PG8_SB(1, 0), cB + kstep, voffB); PG8_STAGE(PG8_SA(1, 0), cA + kstep, voffA); PG8_STAGE(PG8_SB(1, 1), cB + hstep + kstep, voffB);
        PG8_WAIT_V(6); PG8_BAR;
    } else {
        PG8_STAGE(PG8_SB(0, 0), cB, voffB); PG8_STAGE(PG8_SA(0, 0), cA, voffA); PG8_STAGE(PG8_SB(0, 1), cB + hstep, voffB); PG8_STAGE(PG8_SA(0, 1), cA + hstep, voffA);
        if (wr == 1) PG8_BAR;
        PG8_WAIT_V(4); PG8_BAR;
        PG8_STAGE(PG8_SB(1, 0), cB + kstep, voffB); PG8_STAGE(PG8_SA(1, 0), cA + kstep, voffA); PG8_STAGE(PG8_SB(1, 1), cB + hstep + kstep, voffB);
        PG8_WAIT_V(6); PG8_BAR;
    }
    for (;;) {
        const bool has_next = S.next(ui + 1, nxt);
        const char* nA = has_next ? (const char*)g.A + (size_t)nxt.pm * tstep : cA; const char* nB = has_next ? (const char*)g.Bt + (size_t)nxt.pn * tstep : cB;
        for (int t = 0; t < nt; t += 2) {
            const bool last = (t == nt - 2);
            const char* a1 = cA + (size_t)(t + 1) * kstep;
            const char* a2 = last ? nA : cA + (size_t)(t + 2) * kstep; const char* b2 = last ? nB : cB + (size_t)(t + 2) * kstep;
            const char* a3 = a2 + kstep; const char* b3 = b2 + kstep;
            if (last && has_next) S.a_ready(nxt);
            if constexpr (SP2) {
            PG8_LDB(B0, 0, 0); PG8_LDB(B1, 0, 1); PG8_SCHED; PG8_LDA(At, 0, 0); PG8_STAGE(PG8_SA(1, 1), a1 + hstep, voffA);
            PG8_WAIT_V(8); PG8_WAIT_L(0); PG8_BAR; PG8_MMA(0, 0, At, B0); PG8_MMA(0, 1, At, B1); PG8_BAR; PG8_SCHED;
            PG8_LDA(At, 0, 1); PG8_STAGE(PG8_SB(0, 0), b2, voffB); PG8_STAGE(PG8_SB(0, 1), b2 + hstep, voffB); PG8_STAGE(PG8_SA(0, 0), a2, voffA);
            PG8_WAIT_V(8); PG8_WAIT_L(0); PG8_BAR; PG8_MMA(1, 0, At, B0); PG8_MMA(1, 1, At, B1); PG8_BAR; PG8_SCHED;
            PG8_LDB(B0, 1, 0); PG8_LDB(B1, 1, 1); PG8_SCHED; PG8_LDA(At, 1, 0); PG8_STAGE(PG8_SA(0, 1), a2 + hstep, voffA);
            PG8_WAIT_V(8); PG8_WAIT_L(0); PG8_BAR; PG8_MMA(0, 0, At, B0); PG8_MMA(0, 1, At, B1); PG8_BAR; PG8_SCHED;
            PG8_LDA(At, 1, 1); PG8_STAGE(PG8_SB(1, 0), b3, voffB); PG8_STAGE(PG8_SB(1, 1), b3 + hstep, voffB); PG8_STAGE(PG8_SA(1, 0), a3, voffA);
            PG8_WAIT_V(8); PG8_WAIT_L(0); PG8_BAR; PG8_MMA(1, 0, At, B0); PG8_MMA(1, 1, At, B1); PG8_BAR; PG8_SCHED;
            } else {
            PG8_LDB(B0, 0, 0); PG8_SCHED; PG8_LDA(At, 0, 0); PG8_STAGE(PG8_SA(1, 1), a1 + hstep, voffA);
            PG8_WAIT_L(8); PG8_BAR; PG8_WAIT_L(0); PG8_MMA(0, 0, At, B0); PG8_BAR; PG8_SCHED;
            PG8_LDB(B1, 0, 1); PG8_STAGE(PG8_SB(0, 0), b2, voffB);
            PG8_BAR; PG8_WAIT_L(0); PG8_MMA(0, 1, At, B1); PG8_BAR;
            PG8_LDA(At, 0, 1); PG8_STAGE(PG8_SA(0, 0), a2, voffA);
            PG8_BAR; PG8_WAIT_L(0); PG8_MMA(1, 0, At, B0); PG8_BAR; PG8_SCHED;
            PG8_STAGE(PG8_SB(0, 1), b2 + hstep, voffB);
            PG8_WAIT_V(6); PG8_BAR; PG8_MMA(1, 1, At, B1); PG8_BAR;
            PG8_LDB(B0, 1, 0); PG8_SCHED; PG8_LDA(At, 1, 0); PG8_STAGE(PG8_SA(0, 1), a2 + hstep, voffA);
            PG8_WAIT_L(8); PG8_BAR; PG8_WAIT_L(0); PG8_MMA(0, 0, At, B0); PG8_BAR; PG8_SCHED;
            PG8_LDB(B1, 1, 1); PG8_STAGE(PG8_SB(1, 0), b3, voffB);
            PG8_BAR; PG8_WAIT_L(0); PG8_MMA(0, 1, At, B1); PG8_BAR;
            PG8_LDA(At, 1, 1); PG8_STAGE(PG8_SA(1, 0), a3, voffA);
            PG8_BAR; PG8_WAIT_L(0); PG8_MMA(1, 0, At, B0); PG8_BAR; PG8_SCHED;
            PG8_STAGE(PG8_SB(1, 1), b3 + hstep, voffB);
            PG8_WAIT_V(6); PG8_BAR; PG8_MMA(1, 1, At, B1); PG8_BAR;
            }
        }
        if constexpr (ALIGN_EPI) { if (wr == 0) PG8_BAR; }
        if constexpr (!Epi::AFTER_DRAIN) { E(acc, cur, wr, wc, fr, fq); S.done(cur); }
        if (!has_next) break;
#pragma unroll
        for (int a = 0; a < 2; ++a)
#pragma unroll
            for (int b = 0; b < 2; ++b)
#pragma unroll
                for (int m = 0; m < 4; ++m)
#pragma unroll
                    for (int n = 0; n < 2; ++n) acc[a][b][m][n] = (f32x4){0.f, 0.f, 0.f, 0.f};
        cur = nxt; cA = nA; cB = nB; ++ui;
        if constexpr (ALIGN_EPI) { if (wr == 1) PG8_BAR; }
    }
    PG8_WAIT_V(0);
    if constexpr (!ALIGN_EPI) { if (wr == 0) PG8_BAR; }
    PG8_BAR;
    if constexpr (Epi::AFTER_DRAIN) { E.fused(acc, cur, wr, wc, fr, fq, lds, wid, lane); S.done(cur); }
#undef PG8_SA
#undef PG8_SB
#undef PG8_STAGE
#undef PG8_LDA
#undef PG8_LDB
#undef PG8_MMA
#undef PG8_WAIT_V
#undef PG8_WAIT_L
#undef PG8_BAR
#undef PG8_SCHED
}
}
#define GAS __attribute__((address_space(1)))
#define LAS __attribute__((address_space(3)))
typedef unsigned short bf16_t;
typedef unsigned v4u __attribute__((ext_vector_type(4)));
typedef float f32x4 __attribute__((ext_vector_type(4)));
typedef float f32x16 __attribute__((ext_vector_type(16)));
typedef short bf16x8 __attribute__((ext_vector_type(8)));
#define LDS_WAIT() asm volatile("s_waitcnt lgkmcnt(0)" ::: "memory")
#define VM_WAIT() asm volatile("s_waitcnt vmcnt(0)" ::: "memory")
__device__ __forceinline__ unsigned f2bfu(float f) { unsigned u = __builtin_bit_cast(unsigned, f); return (u + 0x7fffu + ((u >> 16) & 1u)) >> 16; }
__device__ __forceinline__ unsigned pk2(float lo, float hi) { return f2bfu(lo) | (f2bfu(hi) << 16); }
__device__ __forceinline__ float bf2f(bf16_t v) { return __uint_as_float(((unsigned)v) << 16); }
__device__ __forceinline__ bf16_t f2bf(float f) { return (bf16_t)f2bfu(f); }
__device__ __forceinline__ int fresh_lane() { int l; asm volatile("v_mbcnt_lo_u32_b32 %0, -1, 0\n\tv_mbcnt_hi_u32_b32 %0, -1, %0" : "=v"(l)); return l; }
__device__ __forceinline__ float wave_sum(float v) {
#pragma unroll
    for (int o = 1; o < 64; o <<= 1) v += __shfl_xor(v, o);
    return v;
}
constexpr int NTOK = 16384, SEQ = 4096, DM = 1024, NB = 4, NH = 8, INC = 2568, NIN = 2816;
constexpr float LOG2E = 1.4426950408889634f;
constexpr size_t MiB = 1u << 20;
constexpr size_t WS_CTL = 0, CTL_ZERO_BYTES = 1 * MiB;
constexpr size_t WS_WIN = 1 * MiB;
constexpr size_t WS_WOUT = 7 * MiB;
constexpr size_t WS_W1F = 9 * MiB;
constexpr size_t WS_W2F = 41 * MiB;
constexpr size_t WS_WLRU = 57 * MiB;
constexpr size_t WS_WR = 57 * MiB + 512 * 1024;
constexpr size_t WS_HN = 58 * MiB;
constexpr size_t WS_AO = WS_HN;
constexpr size_t WS_Q = 90 * MiB, WS_K = 106 * MiB, WS_V = 122 * MiB, WS_GG = 138 * MiB, WS_RI = 154 * MiB;
constexpr size_t WS_XG = 90 * MiB;
constexpr size_t WS_Y = 122 * MiB;
constexpr size_t WS_X1 = 186 * MiB;
constexpr size_t WS_LF = 250 * MiB;
constexpr size_t WS_C2 = 250 * MiB + 512 * 1024;
constexpr size_t WS_SSQP = 251 * MiB;
constexpr size_t WS_RT = 252 * MiB;
constexpr size_t WS_SUM = 252 * MiB + 512 * 1024;
constexpr size_t WS_LIST = 253 * MiB + 512 * 1024;
constexpr size_t WS_END = 256 * MiB;
constexpr int CW_BAR = 4096;
constexpr int CW_CNT = 32768;
constexpr int RING_BYTES = 131072, LDS_BYTES = 147456, MISC_OFF = LDS_BYTES - 512, LDSCTL_OFF = LDS_BYTES - 1024;
#define XB_TMO      128
#define XB_XCNT(j)  (256  + 64 * (j))
#define XB_XSUB(j)  (1280 + 64 * (j))
#define XB_XGEN(j)  (2304 + 64 * (j))
#define XB_TOP      3328
#define XB_TOPGEN   3392
#define XCD_BAR_WORDS 3456
#define XB_SPIN_CAP (1u << 18)

__device__ __forceinline__ unsigned xb_ld(unsigned* p)              { return __hip_atomic_load(p, __ATOMIC_RELAXED, __HIP_MEMORY_SCOPE_AGENT); }
__device__ __forceinline__ unsigned xb_add(unsigned* p, unsigned v) { return __hip_atomic_fetch_add(p, v, __ATOMIC_RELAXED, __HIP_MEMORY_SCOPE_AGENT); }
__device__ __forceinline__ unsigned xb_xcc_id() { return (unsigned)__builtin_amdgcn_s_getreg((3 << 11) | 20) & 0xFu; }
#define XB_SPIN(cond, bar) do { unsigned _sp = 0; while (cond) { __builtin_amdgcn_s_sleep(1); \
    if ((++_sp & 255u) == 0u) { if (xb_ld(&(bar)[XB_TMO])) break; if (_sp > XB_SPIN_CAP) { atomicAdd(&(bar)[XB_TMO], 1u); break; } } } } while (0)

struct XcdBarrier {
    unsigned* bar; unsigned x;
    volatile LAS unsigned* st;
};

__device__ __forceinline__ XcdBarrier xcd_barrier_post(unsigned* bar, volatile LAS unsigned* st) {
    XcdBarrier b; b.bar = bar; b.x = xb_xcc_id(); b.st = st;
    if (threadIdx.x == 0) (void)xb_add(&bar[XB_XCNT(b.x)], 1u);
    return b;
}
__device__ __forceinline__ void xcd_barrier_complete(unsigned* bar, unsigned x, unsigned& nloc, unsigned& nx) {
    const unsigned G = gridDim.x * gridDim.y * gridDim.z;
    unsigned sum, cnt, mine, sp = 0u;
    for (;;) {
        sum = 0u; cnt = 0u; mine = 0u;
#pragma unroll
        for (unsigned j = 0; j < 16; ++j) { const unsigned c = xb_ld(&bar[XB_XCNT(j)]); sum += c; cnt += (c > 0u) ? 1u : 0u; mine = (j == x) ? c : mine; }
        if (sum == G) break;
        __builtin_amdgcn_s_sleep(1);
        if ((++sp & 255u) == 0u) { if (xb_ld(&bar[XB_TMO])) break; if (sp > XB_SPIN_CAP) { atomicAdd(&bar[XB_TMO], 1u); break; } }
    }
    nloc = mine > 0u ? mine : 1u; nx = cnt > 0u ? cnt : 1u;
}

__device__ __forceinline__ void xcd_barrier_thread0(const XcdBarrier& b) {
        unsigned* bar = b.bar;
        __builtin_amdgcn_s_waitcnt(0);
        unsigned nloc = b.st[0], nx = b.st[1];
        if (nloc == 0u) { xcd_barrier_complete(bar, b.x, nloc, nx); b.st[0] = nloc; b.st[1] = nx; }
        const unsigned old = xb_add(&bar[XB_XSUB(b.x)], 1u);
        const unsigned gen = old / nloc;
        if (old + 1u == (gen + 1u) * nloc) {
            __builtin_amdgcn_fence(__ATOMIC_RELEASE, "agent");
            asm volatile("s_waitcnt vmcnt(0)" ::: "memory");
            const unsigned og = xb_add(&bar[XB_TOP], 1u);
            const unsigned tg = og / nx;
            if (og + 1u == (tg + 1u) * nx) xb_add(&bar[XB_TOPGEN], 1u);
            else XB_SPIN(xb_ld(&bar[XB_TOPGEN]) == tg, bar);
            __builtin_amdgcn_fence(__ATOMIC_ACQUIRE, "agent");
            xb_add(&bar[XB_XGEN(b.x)], 1u);
            asm volatile("s_waitcnt vmcnt(0)" ::: "memory");
        } else {
            XB_SPIN(xb_ld(&bar[XB_XGEN(b.x)]) == gen, bar);
            __builtin_amdgcn_fence(__ATOMIC_ACQUIRE, "agent");
            asm volatile("s_waitcnt vmcnt(0)" ::: "memory");
        }
}
__device__ __forceinline__ void xcd_barrier(const XcdBarrier& b) {
    asm volatile("s_waitcnt vmcnt(0)" ::: "memory");
    __syncthreads();
    if (threadIdx.x == 0) xcd_barrier_thread0(b);
    __syncthreads();
}
template <class F> __device__ __forceinline__ void xcd_barrier_work(const XcdBarrier& b, int wave, F work) {
    asm volatile("s_waitcnt vmcnt(0)" ::: "memory");
    __syncthreads();
    if (wave == 0) { if (threadIdx.x == 0) xcd_barrier_thread0(b); }
    else work();
    __syncthreads();
}
#include <hip/hip_bf16.h>
namespace attn_body {
using bf16=__hip_bfloat16;
using bf16x8=__attribute__((ext_vector_type(8)))short;
using s16x4=__attribute__((ext_vector_type(4)))short;
using f32x16=__attribute__((ext_vector_type(16)))float;
using u32x4=__attribute__((ext_vector_type(4)))unsigned;
using u32x2=__attribute__((ext_vector_type(2)))unsigned;
constexpr int BATCH=4,NHEAD=8,SEQ=4096,D=64,DM=NHEAD*D,OPITCH=1024;
constexpr int NW=8,QBLK=32,QB=QBLK*NW,KVBLK=64,NQB=SEQ/QB;
constexpr int ATTN_PITCH=DM, ATTN_UNIT_ROWS=QB;
__device__ __forceinline__ int crow(int r,int hi){return (r&3)+8*(r>>2)+4*hi;}
#define SBAR() __builtin_amdgcn_sched_barrier(0)
__device__ __forceinline__ void cmask(f32x16&p0,f32x16&p1,int jb,int qrel,int hi){
  const float NEG=-INFINITY; int kb=64*jb+4*hi;
  #pragma unroll
  for(int r=0;r<16;++r){int kv=kb+(r&3)+8*(r>>2); if(kv>qrel)p0[r]=NEG; if(kv+32>qrel)p1[r]=NEG;}
}

constexpr int NSLOT=3, SLOTB=8192;
constexpr int LDS_K=0, LDS_V=NSLOT*SLOTB, LDS_WS=2*NSLOT*SLOTB, LDS_OST=LDS_WS+NW*64*4, LDS_BYTES=LDS_OST+NW*4096; constexpr int LDS_CK=LDS_BYTES, LDS_CKW=LDS_CK+SEQ*4, LDS_KA=LDS_CKW+64, LDS_TOTAL=LDS_KA+SEQ*8;
constexpr float C2=0.125f*1.4426950408889634f;
__device__ __forceinline__ void glds16(const void*gsrc,unsigned lds_dst){unsigned keep;
  asm volatile("s_mov_b32 %0, m0\n\ts_mov_b32 m0, %2\n\ts_nop 0\n\tglobal_load_lds_dwordx4 %1, off\n\ts_mov_b32 m0, %0":"=&s"(keep):"v"(gsrc),"s"(lds_dst):"memory");}
__device__ __forceinline__ float max3f(float a,float b,float c){float r;asm("v_max3_f32 %0, %1, %2, %3":"=v"(r):"v"(a),"v"(b),"v"(c));return r;}
__device__ __forceinline__ float max2f(float a,float b){float r;asm("v_max_f32_e32 %0, %1, %2":"=v"(r):"v"(a),"v"(b));return r;}
__device__ __forceinline__ float fadd_s(float a,float b){float r;asm("v_add_f32_e32 %0, %1, %2":"=v"(r):"v"(a),"v"(b));return r;}
__device__ __forceinline__ float fsub_s(float a,float b){float r;asm("v_sub_f32_e32 %0, %1, %2":"=v"(r):"v"(a),"v"(b));return r;}
typedef float f32x2_t __attribute__((ext_vector_type(2))); typedef __bf16 bf16x2_t __attribute__((ext_vector_type(2)));
__device__ __forceinline__ unsigned cvtpk_s(float lo,float hi){f32x2_t v={lo,hi};bf16x2_t b=__builtin_convertvector(v,bf16x2_t);return __builtin_bit_cast(unsigned,b);}
#define WAIT_BAR(N) asm volatile("s_waitcnt vmcnt(" #N ") lgkmcnt(0)\n\ts_barrier":::"memory")

__device__ __forceinline__ void qkt(f32x16&p0,f32x16&p1,const char*Kslot,const bf16x8*qr,int r32,int hi){
  const char*kb=Kslot+hi*1024+r32*16;
  #pragma unroll
  for(int d0=0;d0<4;++d0){
    const bf16x8 b0=*reinterpret_cast<const bf16x8*>(kb+d0*2048);
    const bf16x8 b1=*reinterpret_cast<const bf16x8*>(kb+d0*2048+512);
    p0=__builtin_amdgcn_mfma_f32_32x32x16_bf16(b0,qr[d0],p0,0,0,0);p1=__builtin_amdgcn_mfma_f32_32x32x16_bf16(b1,qr[d0],p1,0,0,0);}
}
typedef __attribute__((address_space(3))) const char* lds_cptr;
typedef short v4i16_t __attribute__((ext_vector_type(4)));
__device__ __forceinline__ void kload8(bf16x8*kf,lds_cptr kp){
  kf[0]=*(const __attribute__((address_space(3))) bf16x8*)(kp);      kf[1]=*(const __attribute__((address_space(3))) bf16x8*)(kp+512);
  kf[2]=*(const __attribute__((address_space(3))) bf16x8*)(kp+2048); kf[3]=*(const __attribute__((address_space(3))) bf16x8*)(kp+2560);
  kf[4]=*(const __attribute__((address_space(3))) bf16x8*)(kp+4096); kf[5]=*(const __attribute__((address_space(3))) bf16x8*)(kp+4608);
  kf[6]=*(const __attribute__((address_space(3))) bf16x8*)(kp+6144); kf[7]=*(const __attribute__((address_space(3))) bf16x8*)(kp+6656);
}
__device__ __forceinline__ void kload2(bf16x8*kf,lds_cptr kp,int j){ kf[2*j]=*(const __attribute__((address_space(3))) bf16x8*)(kp+j*2048); kf[2*j+1]=*(const __attribute__((address_space(3))) bf16x8*)(kp+j*2048+512); }
__device__ __forceinline__ s16x4 vtr(lds_cptr p){ return __builtin_bit_cast(s16x4,__builtin_amdgcn_ds_read_tr16_b64_v4i16((__attribute__((address_space(3))) v4i16_t*)p)); }
__device__ __forceinline__ float rowmax(const f32x16&p0,const f32x16&p1){
  float a=max3f(p0[0],p0[1],p1[0]),b=max3f(p0[2],p0[3],p1[1]);a=max3f(a,p1[2],p1[3]);
  #pragma unroll
  for(int r=4;r<16;r+=4){a=max3f(a,p0[r],p0[r+1]);b=max3f(b,p0[r+2],p0[r+3]);a=max3f(a,p1[r],p1[r+1]);b=max3f(b,p1[r+2],p1[r+3]);}
  const float m=max2f(a,b);
  auto rr=__builtin_amdgcn_permlane32_swap(__float_as_uint(m),__float_as_uint(m),false,false);
  return max2f(__uint_as_float(rr[0]),__uint_as_float(rr[1]));
}
__device__ __forceinline__ void pv(f32x16*o,int vb,bf16x8 pa0,bf16x8 pa1,bf16x8 pa2,bf16x8 pa3){
  #pragma unroll
  for(int d0=0;d0<2;++d0){s16x4 lo[4],hi[4];
    #pragma unroll
    for(int ks=0;ks<4;++ks){
      asm volatile("ds_read_b64_tr_b16 %0,%1 offset:%c2":"=&v"(lo[ks]):"v"(vb),"i"(d0*4096+ks*1024):"memory");
      asm volatile("ds_read_b64_tr_b16 %0,%1 offset:%c2":"=&v"(hi[ks]):"v"(vb),"i"(d0*4096+ks*1024+512):"memory");}
    asm volatile("s_waitcnt lgkmcnt(0)":::"memory");SBAR();
    #define PK(k) (bf16x8){lo[k][0],lo[k][1],lo[k][2],lo[k][3],hi[k][0],hi[k][1],hi[k][2],hi[k][3]}
    o[d0]=__builtin_amdgcn_mfma_f32_32x32x16_bf16(pa0,PK(0),o[d0],0,0,0);
    o[d0]=__builtin_amdgcn_mfma_f32_32x32x16_bf16(pa1,PK(1),o[d0],0,0,0);
    o[d0]=__builtin_amdgcn_mfma_f32_32x32x16_bf16(pa2,PK(2),o[d0],0,0,0);
    o[d0]=__builtin_amdgcn_mfma_f32_32x32x16_bf16(pa3,PK(3),o[d0],0,0,0);
    #undef PK
  }
}

#ifndef ATTN_STORE16
#define ATTN_STORE16(p,v) (*(u32x4*)(p)=(v))
#endif
template<int THRL> __device__ __forceinline__ void attn_unit(int b,int h,int qb,const bf16*Q,const bf16*__restrict__ K,const bf16*__restrict__ V,bf16*O,const float*LF,char*shm,bool build_ck){
  const int tid=threadIdx.x,lane=tid&63,r32=lane&31,hi=lane>>5; const int wid=__builtin_amdgcn_readfirstlane(tid>>6);
  const long rowbase=(long)b*SEQ; const int q0=qb*QB;
  if(build_ck){ const int n=q0+QB; const float*lfp=LF+(size_t)(b*NHEAD+h)*SEQ; const int r0=tid*8;
    typedef float f4_t __attribute__((ext_vector_type(4)));
    float v[8];
    if(r0<n){ const f4_t a=*(const f4_t*)(lfp+(n-8-r0)), c=*(const f4_t*)(lfp+(n-4-r0)); v[0]=c[3];v[1]=c[2];v[2]=c[1];v[3]=c[0];v[4]=a[3];v[5]=a[2];v[6]=a[1];v[7]=a[0]; }
    else { _Pragma("unroll") for(int i=0;i<8;++i)v[i]=0.f; }
    float e[8]; e[0]=0.f; _Pragma("unroll") for(int i=1;i<8;++i)e[i]=e[i-1]+v[i-1];
    const float tot=e[7]+v[7]; float x=tot;
    int lo_=lane; asm volatile("":"+v"(lo_));
    _Pragma("unroll") for(int o=1;o<64;o<<=1){ const float y=__int_as_float(__builtin_amdgcn_ds_bpermute((lo_-o)<<2,__float_as_int(x))); if(lo_>=o)x+=y; }
    __attribute__((address_space(3))) float*ckw=(__attribute__((address_space(3))) float*)((lds_cptr)shm+LDS_CKW);
    __attribute__((address_space(3))) float*ckp=(__attribute__((address_space(3))) float*)((lds_cptr)shm+LDS_CK);
    if(lo_==63)ckw[wid]=x;
    asm volatile("s_waitcnt lgkmcnt(0)\n\ts_barrier":::"memory");
    float base=0.f; _Pragma("unroll") for(int w=0;w<8;++w){ const float tw=ckw[w]; if(w<wid)base+=tw; }
    const float ex=base+(x-tot);
    __attribute__((address_space(3))) u32x2*kap=(__attribute__((address_space(3))) u32x2*)((lds_cptr)shm+LDS_KA);
    if(r0<n){ _Pragma("unroll") for(int i=0;i<8;++i){ const float xv=-1.4426950408889634f*(ex+e[i]); ckp[n-1-r0-i]=xv;
      const unsigned ph=cvtpk_s(xv,0.f)&0xffffu; const float r1=xv-__uint_as_float(ph<<16); const unsigned pm=cvtpk_s(r1,0.f)&0xffffu; const float r2=r1-__uint_as_float(pm<<16); const unsigned pl=cvtpk_s(r2,0.f)&0xffffu;
      kap[n-1-r0-i]=(u32x2){ph|(pm<<16),pl|0x3F800000u}; } }
    asm volatile("s_waitcnt lgkmcnt(0)\n\ts_barrier":::"memory");
  }
  const bf16*Qw=Q+(rowbase+q0+wid*QBLK)*DM+h*D;
  const bf16*Kh=K+rowbase*DM+h*D,*Vh=V+rowbase*DM+h*D;
  const unsigned lds0=(unsigned)(uintptr_t)shm;
  float*wsf=(float*)(shm+LDS_WS)+wid*64;
  const bf16*ksrc=Kh+(long)lane*DM+wid*8;
  const bf16*vsrc=Vh+(long)(16*(wid&3)+(lane>>2))*DM+(wid>>2)*32+(lane&3)*8;
  const unsigned kdst=lds0+LDS_K+wid*1024, vdst=lds0+LDS_V+wid*1024;
  #define DMA_K(t,slot) glds16(ksrc+(long)(t)*KVBLK*DM,(unsigned)__builtin_amdgcn_readfirstlane(kdst+(slot)))
  #define DMA_V(t,slot) glds16(vsrc+(long)(t)*KVBLK*DM,(unsigned)__builtin_amdgcn_readfirstlane(vdst+(slot)))
  const int vb0=(int)(lds0+LDS_V)+((lane>>4)&1)*32+(lane&3)*8+(4*hi+((lane&15)>>2))*64;
  const char*Kbase=shm+LDS_K; bf16x8 kf[8];
  const lds_cptr shm3=(lds_cptr)shm; const lds_cptr kp0=shm3+LDS_K+hi*1024+r32*16; const lds_cptr vp0=shm3+LDS_V+((lane>>4)&1)*32+(lane&3)*8+(4*hi+((lane&15)>>2))*64;
  const int NT=(q0+QB)/KVBLK;
  DMA_K(0,0);DMA_V(0,0);DMA_K(1,SLOTB);
  bf16x8 qr[4];
  #pragma unroll
  for(int d0=0;d0<4;++d0)qr[d0]=*reinterpret_cast<const bf16x8*>(&Qw[(long)r32*DM+d0*16+hi*8]);
  float mhat=0.f,l_reg=0.f;f32x16 o[2];o[0]=f32x16{};o[1]=f32x16{};
  const int qrel=wid*QBLK+r32;
  typedef float f4_t __attribute__((ext_vector_type(4)));
  const __attribute__((address_space(3))) float*ckb=(const __attribute__((address_space(3))) float*)((lds_cptr)shm+LDS_CK);
  const float cq=ckb[q0+qrel];
  const __attribute__((address_space(3))) u32x2*kab=(const __attribute__((address_space(3))) u32x2*)((lds_cptr)shm+LDS_KA)+r32;
  u32x4 qaug; u32x2 kaw0,kaw1; const f32x16 z16=f32x16{};
  #define QAUG() do{ const float a_=cq-mhat; const unsigned ph_=cvtpk_s(a_,0.f)&0xffffu; const float r1_=a_-__uint_as_float(ph_<<16); const unsigned pm_=cvtpk_s(r1_,0.f)&0xffffu; \
    const unsigned pl_=cvtpk_s(r1_-__uint_as_float(pm_<<16),0.f)&0xffffu; qaug=hi?(u32x4){0u,0u,0u,0u}:(u32x4){0xBF80BF80u,0xBF80u|(ph_<<16),pm_|(pl_<<16),0u}; }while(0)
  #define KAL(tt) do{ kaw0=kab[64*(tt)]; kaw1=kab[64*(tt)+32]; }while(0)
  #define KAF(w) __builtin_bit_cast(bf16x8,(u32x4){w[0],w[1],0x3F803F80u,0u})
  #define QAF __builtin_bit_cast(bf16x8,qaug)
  #define AUGM(X0,X1) do{ X0=__builtin_amdgcn_mfma_f32_32x32x16_bf16(KAF(kaw0),QAF,z16,0,0,0); X1=__builtin_amdgcn_mfma_f32_32x32x16_bf16(KAF(kaw1),QAF,z16,0,0,0); }while(0)
  #define CMASK(P0,P1,t) do{int jb_=(t)-(NT-4); if(jb_>=0)cmask(P0,P1,jb_,qrel,hi);}while(0)
  bool resc=false;
  #define START(P0,P1) do{ const float rm=rowmax(P0,P1); resc=false; \
    { const float dl=rm; mhat=fadd_s(mhat,dl); \
      _Pragma("unroll") for(int r=0;r<16;++r){P0[r]=fsub_s(P0[r],dl);P1[r]=fsub_s(P1[r],dl);} } \
    _Pragma("unroll") for(int r=0;r<16;++r)P0[r]=__builtin_amdgcn_exp2f(P0[r]); }while(0)
  #define RESC() do{ if(resc){ asm volatile("s_waitcnt lgkmcnt(0)":::"memory"); \
      _Pragma("unroll") for(int d_=0;d_<2;++d_) _Pragma("unroll") for(int r=0;r<16;++r)o[d_][r]*=wsf[crow(r,hi)]; } }while(0)
  f32x16 pA0,pA1,pB0,pB1;
  int sl_prev=0,sl_cur=0,sl_next=SLOTB;
  #define ROT() do{sl_prev=sl_cur;sl_cur=sl_next;sl_next=(sl_next==(NSLOT-1)*SLOTB)?0:sl_next+SLOTB;}while(0)
  DMA_K(2,2*SLOTB);
  WAIT_BAR(3);
  QAUG(); KAL(0); AUGM(pA0,pA1);
  qkt(pA0,pA1,Kbase,qr,r32,hi);asm volatile("s_nop 15\n\ts_nop 7":"+v"(pA0),"+v"(pA1));CMASK(pA0,pA1,0);
  START(pA0,pA1);
  QAUG(); KAL(1); AUGM(pB0,pB1);
  _Pragma("unroll") for(int r=0;r<16;++r)pA1[r]=__builtin_amdgcn_exp2f(pA1[r]);
  WAIT_BAR(0);
  DMA_K(3,0);DMA_V(1,SLOTB);
  ROT();
  kload8(kf,kp0+sl_cur);
  WAIT_BAR(2);
  s16x4 vlo[8],vhi[8]; u32x4 pw0,pw1,pw2,pw3;
  #define PKW(P,B) cvtpk_s(P[B],P[B+1])
  #define PAF(k) __builtin_bit_cast(bf16x8,pw##k)
  #define VFR(i) (bf16x8){vlo[i][0],vlo[i][1],vlo[i][2],vlo[i][3],vhi[i][0],vhi[i][1],vhi[i][2],vhi[i][3]}
  #define PIN(x) asm volatile("":"+v"(x))
  #define MX3(a,b,c) __builtin_fmaxf(__builtin_fmaxf((a),(b)),(c))
  #define GAPA(MF,A0,A1,A2,A3,W0,W1,PW) do{ MF; sacc+=A0; sacc+=A1; sacc+=A2; sacc+=A3; PIN(sacc); W0; W1; PIN(PW); SBAR(); }while(0)
  #define EX(v) __builtin_amdgcn_exp2f(v)
  #define GAPB(MF,X,B) do{ MF; X[B]=EX(X[B]); X[B+1]=EX(X[B+1]); X[B+2]=EX(X[B+2]); X[B+3]=EX(X[B+3]); PIN(X); SBAR(); }while(0)
  #define VRD(i) do{ vlo[i]=vtr(vp_+(((i)>>2)*4096+((i)&3)*1024)); vhi[i]=vtr(vp_+(((i)>>2)*4096+((i)&3)*1024+512)); }while(0)
  #define KRD(G,j) do{ if(G){ kload2(kf,kp0+sl_next,j); SBAR(); } }while(0)
  #define STEP(C0,C1,P0,P1,t,GK,GV,GL,GI) do{ SBAR(); \
    const lds_cptr vp_=vp0+sl_prev; \
    if(GI){ KAL((t)+1); } \
    VRD(0); SBAR(); float sacc=(P0[0]+P0[1]); \
    GAPA(C0=__builtin_amdgcn_mfma_f32_32x32x16_bf16(kf[0],qr[0],C0,0,0,0), P0[2],P0[3],P0[4],P0[5],     pw0[0]=PKW(P0,0), pw0[1]=PKW(P0,2), pw0); \
    VRD(4); SBAR(); GAPA(C1=__builtin_amdgcn_mfma_f32_32x32x16_bf16(kf[1],qr[0],C1,0,0,0), P0[6],P0[7],P0[8],P0[9],     pw0[2]=PKW(P0,4), pw0[3]=PKW(P0,6), pw0); \
    VRD(1); SBAR(); GAPA(C0=__builtin_amdgcn_mfma_f32_32x32x16_bf16(kf[2],qr[1],C0,0,0,0),   P0[10],P0[11],P0[12],P0[13], pw1[0]=PKW(P0,8), pw1[1]=PKW(P0,10), pw1); \
    VRD(5); SBAR(); GAPA(C1=__builtin_amdgcn_mfma_f32_32x32x16_bf16(kf[3],qr[1],C1,0,0,0),   P0[14],P0[15],P1[0],P1[1],   pw1[2]=PKW(P0,12),pw1[3]=PKW(P0,14), pw1); \
    VRD(2); SBAR(); GAPA(C0=__builtin_amdgcn_mfma_f32_32x32x16_bf16(kf[4],qr[2],C0,0,0,0),   P1[2],P1[3],P1[4],P1[5],     pw2[0]=PKW(P1,0), pw2[1]=PKW(P1,2), pw2); \
    VRD(6); SBAR(); GAPA(C1=__builtin_amdgcn_mfma_f32_32x32x16_bf16(kf[5],qr[2],C1,0,0,0),   P1[6],P1[7],P1[8],P1[9],     pw2[2]=PKW(P1,4), pw2[3]=PKW(P1,6), pw2); \
    VRD(3); SBAR(); GAPA(C0=__builtin_amdgcn_mfma_f32_32x32x16_bf16(kf[6],qr[3],C0,0,0,0),   P1[10],P1[11],P1[12],P1[13], pw3[0]=PKW(P1,8), pw3[1]=PKW(P1,10), pw3); \
    VRD(7); SBAR(); GAPA(C1=__builtin_amdgcn_mfma_f32_32x32x16_bf16(kf[7],qr[3],C1,0,0,0),   P1[14],P1[15],0.f,0.f,       pw3[2]=PKW(P1,12),pw3[3]=PKW(P1,14), pw3); \
    l_reg+=sacc; \
    if(GK){DMA_K((t)+3,sl_cur);} if(GV){DMA_V((t)+1,sl_next);} \
    CMASK(C0,C1,t); \
    { float a=MX3(C0[0],C0[1],C1[0]),b=MX3(C0[2],C0[3],C1[1]); a=MX3(a,C1[2],C1[3]); \
      _Pragma("unroll") for(int r=4;r<16;r+=4){a=MX3(a,C0[r],C0[r+1]);b=MX3(b,C0[r+2],C0[r+3]);a=MX3(a,C1[r],C1[r+1]);b=MX3(b,C1[r+2],C1[r+3]);} \
      float rm=__builtin_fmaxf(a,b); { auto rr=__builtin_amdgcn_permlane32_swap(__float_as_uint(rm),__float_as_uint(rm),false,false); rm=__builtin_fmaxf(__uint_as_float(rr[0]),__uint_as_float(rr[1])); } \
      resc=false; \
      if(__builtin_expect(__any(rm>(float)THRL),0)){ const float dl=__builtin_fmaxf(rm,0.f); mhat+=dl; QAUG(); \
        _Pragma("unroll") for(int r=0;r<16;++r){C0[r]-=dl;C1[r]-=dl;} \
        const float f=__builtin_amdgcn_exp2f(-dl); l_reg*=f; if(hi==0)wsf[r32]=f; resc=true; } } \
    if(GI){ AUGM(P0,P1); } \
    SBAR(); \
    GAPB(o[0]=__builtin_amdgcn_mfma_f32_32x32x16_bf16(PAF(0),VFR(0),o[0],0,0,0), C0,0); \
    GAPB(o[1]=__builtin_amdgcn_mfma_f32_32x32x16_bf16(PAF(0),VFR(4),o[1],0,0,0), C0,4); \
    KRD(GL,0); GAPB(o[0]=__builtin_amdgcn_mfma_f32_32x32x16_bf16(PAF(1),VFR(1),o[0],0,0,0), C0,8); \
    KRD(GL,1); GAPB(o[1]=__builtin_amdgcn_mfma_f32_32x32x16_bf16(PAF(1),VFR(5),o[1],0,0,0), C0,12); \
    KRD(GL,2); GAPB(o[0]=__builtin_amdgcn_mfma_f32_32x32x16_bf16(PAF(2),VFR(2),o[0],0,0,0), C1,0); \
    KRD(GL,3); GAPB(o[1]=__builtin_amdgcn_mfma_f32_32x32x16_bf16(PAF(2),VFR(6),o[1],0,0,0), C1,4); \
    GAPB(o[0]=__builtin_amdgcn_mfma_f32_32x32x16_bf16(PAF(3),VFR(3),o[0],0,0,0), C1,8); \
    GAPB(o[1]=__builtin_amdgcn_mfma_f32_32x32x16_bf16(PAF(3),VFR(7),o[1],0,0,0), C1,12); \
    }while(0)
  int t=1;
  #undef CMASK
  #define CMASK(P0,P1,t) do{}while(0)
  for(;t+5<NT;t+=2){
    STEP(pB0,pB1,pA0,pA1,t,true,true,true,true);     WAIT_BAR(2); RESC(); ROT();
    STEP(pA0,pA1,pB0,pB1,t+1,true,true,true,true);   WAIT_BAR(2); RESC(); ROT();
  }
  #undef CMASK
  #define CMASK(P0,P1,t) do{int jb_=(t)-(NT-4); if(jb_>=0)cmask(P0,P1,jb_,qrel,hi);}while(0)
  #define ENDW(tt) do{ if((tt)+3<NT){WAIT_BAR(2);} else if((tt)+2<NT){WAIT_BAR(1);} else {WAIT_BAR(0);} }while(0)
  for(;t+1<NT;t+=2){
    STEP(pB0,pB1,pA0,pA1,t,(t+3<NT),(t+1<NT),(t+1<NT),(t+1<NT));       ENDW(t);   RESC(); ROT();
    STEP(pA0,pA1,pB0,pB1,t+1,(t+4<NT),(t+2<NT),(t+2<NT),(t+2<NT));     ENDW(t+1); RESC(); ROT();
  }
  STEP(pB0,pB1,pA0,pA1,NT-1,false,false,false,false); RESC();
  { float sacc=pB0[0]+pB0[1]; _Pragma("unroll") for(int r=2;r<16;++r)sacc+=pB0[r]; _Pragma("unroll") for(int r=0;r<16;++r)sacc+=pB1[r]; l_reg+=sacc;
    pw0=(u32x4){PKW(pB0,0),PKW(pB0,2),PKW(pB0,4),PKW(pB0,6)};pw1=(u32x4){PKW(pB0,8),PKW(pB0,10),PKW(pB0,12),PKW(pB0,14)};pw2=(u32x4){PKW(pB1,0),PKW(pB1,2),PKW(pB1,4),PKW(pB1,6)};pw3=(u32x4){PKW(pB1,8),PKW(pB1,10),PKW(pB1,12),PKW(pB1,14)};
    SBAR(); pv(o,vb0+sl_cur,PAF(0),PAF(1),PAF(2),PAF(3)); }
  #undef PKW
  #undef PAF
  #undef VFR
  #undef PIN
  #undef MX3
  #undef GAPA
  #undef GAPB
  #undef EX
  #undef VRD
  #undef KRD
  #undef STEP
  #undef ENDW
  {auto rr=__builtin_amdgcn_permlane32_swap(__float_as_uint(l_reg),__float_as_uint(l_reg),false,false);l_reg=__uint_as_float(rr[0])+__uint_as_float(rr[1]);}
  if(hi==0)wsf[32+r32]=l_reg;asm volatile("s_waitcnt lgkmcnt(0)":::"memory");
  float rli[16];
  #pragma unroll
  for(int r=0;r<16;++r)rli[r]=__builtin_amdgcn_rcpf(wsf[32+crow(r,hi)]);
  bf16*Ow=O+(rowbase+q0+wid*QBLK)*OPITCH+h*D;
  { bf16*stg=(bf16*)(shm+LDS_OST)+wid*2048;
    #pragma unroll
    for(int r=0;r<16;++r){const int orow=crow(r,hi);
      #pragma unroll
      for(int d0=0;d0<2;++d0)stg[orow*64+d0*32+r32]=__float2bfloat16(o[d0][r]*rli[r]);}
    asm volatile("s_waitcnt lgkmcnt(0)":::"memory");
    #pragma unroll
    for(int i=0;i<4;++i){const int row=i*8+(lane>>3),ch=lane&7; const u32x4 v=*(const u32x4*)(stg+row*64+ch*8); ATTN_STORE16(Ow+(long)row*OPITCH+ch*8,v);} }
  asm volatile("s_waitcnt lgkmcnt(0)\n\ts_barrier":::"memory");
  #undef DMA_K
  #undef DMA_V
  #undef CMASK
  #undef START
  #undef RESC
  #undef ROT
  #undef QAUG
  #undef KAL
  #undef KAF
  #undef QAF
  #undef AUGM
}
constexpr int ATTN_LDS_BYTES=LDS_TOTAL;
struct AttnTensors { const bf16* Q; const bf16* K; const bf16* V; bf16* O; const float* LF; };
struct AttnUnit { int bh; int qb; };
struct StaticOrder {
  int vcu;
  __device__ __forceinline__ explicit StaticOrder(int grid,int block):vcu((block%8)*(grid/8)+block/8){}
  __device__ __forceinline__ bool next(int i,AttnUnit&u)const{ if(i>=2)return false; const int s=vcu&7; u.bh=vcu>>3; u.qb=(i==0)?15-s:s; return true; }
  __device__ __forceinline__ void a_ready(const AttnUnit&)const{}
  __device__ __forceinline__ void done(const AttnUnit&)const{}
};
template<class Sched,int THRL=8> __device__ __forceinline__ void attn_phase(char*lds,const AttnTensors&T,const Sched&S){
  AttnUnit u;
  for(int i=0;S.next(i,u);++i){ S.a_ready(u); attn_unit<THRL>(u.bh/NHEAD,u.bh%NHEAD,u.qb,T.Q,T.K,T.V,T.O,T.LF,lds,i==0); S.done(u); }
}
#undef SBAR
#undef WAIT_BAR
}
__device__ __forceinline__ void p0_transpose_item(const float* W, int K, int ldw, int src_col0, int nvalid, bf16_t* WT, int n0, int k0, LAS float* scr, int lane, const float* kgain) {
#pragma unroll 8
    for (int i = 0; i < 32; ++i) { const int kk = 2 * i + (lane >> 5), l = lane & 31; scr[kk * 33 + l] = (l < nvalid) ? W[(size_t)(k0 + kk) * ldw + src_col0 + l] * (kgain ? kgain[k0 + kk] : 1.0f) : 0.f; }
    LDS_WAIT(); asm volatile("" ::: "memory");
    const int c = lane & 7;
#pragma unroll
    for (int j = 0; j < 4; ++j) { const int n = (lane >> 3) + 8 * j; const LAS float* s = scr + (8 * c) * 33 + n;
        v4u o; o.x = pk2(s[0 * 33], s[1 * 33]); o.y = pk2(s[2 * 33], s[3 * 33]); o.z = pk2(s[4 * 33], s[5 * 33]); o.w = pk2(s[6 * 33], s[7 * 33]);
        *(GAS v4u*)(WT + (size_t)(n0 + n) * K + k0 + 8 * c) = o; }
    LDS_WAIT(); asm volatile("" ::: "memory");
}
__device__ __forceinline__ void row_to_bf16_inv(const float* xrow, bf16_t* orow, float* invp, int lane) {
    const GAS f32x4* xr = (const GAS f32x4*)xrow + lane;
    f32x4 v[4]; float s = 0.f;
#pragma unroll
    for (int j = 0; j < 4; ++j) { v[j] = xr[64 * j]; s += (v[j].x * v[j].x + v[j].y * v[j].y) + (v[j].z * v[j].z + v[j].w * v[j].w); }
    const float inv = 1.0f / sqrtf(wave_sum(s) * (1.f / DM) + 1e-6f);
    GAS unsigned long long* o8 = (GAS unsigned long long*)orow + lane;
#pragma unroll
    for (int j = 0; j < 4; ++j) o8[64 * j] = (unsigned long long)pk2(v[j].x, v[j].y) | ((unsigned long long)pk2(v[j].z, v[j].w) << 32);
    if (lane == 0) *invp = inv;
}
namespace lru {
constexpr int ROWB = 144, TILE_B = 67 * ROWB  , CW_OFF = 9728, WAVE_LDS = 11264;
__device__ __forceinline__ float fast_sigmoid(float z) { return __builtin_amdgcn_rcpf(1.0f + __builtin_amdgcn_exp2f(-1.4426950408889634f * z)); }
__device__ __forceinline__ void stage1(int item, int wave, int lane, LAS unsigned char* Lw, const bf16_t* ri, const bf16_t* wlru, const float* cw, const float* cb,
                                       const float* ba, const float* bx, const float* lam, float* sumP, float* sumH, f32x16 (&Pc)[2][2], f32x16 (&Hl)[2][2]) {
    const int b = item >> 6, c = item & 63, t0 = c * 64; const size_t n0 = (size_t)b * SEQ + t0;
    const int r32 = lane & 31, hi = lane >> 5, chb = wave * 64;
#pragma unroll
    for (int pass = 0; pass < 9; ++pass) { const int row = pass * 8 + (lane >> 3);
        if (row < 67) { v4u val = (v4u){0u, 0u, 0u, 0u}; if (t0 - 3 + row >= 0) val = *(const GAS v4u*)(ri + (n0 + row - 3) * 512 + chb + 8 * (lane & 7));
            *(LAS v4u*)(Lw + row * ROWB + (lane & 7) * 16) = val; } }
    LAS float* cwl = (LAS float*)(Lw + CW_OFF);
#pragma unroll
    for (int tap = 0; tap < 4; ++tap) cwl[tap * 64 + lane] = cw[tap * 512 + chb + lane];
    cwl[256 + lane] = cb[chb + lane];
    bf16x8 bfa[8];
#pragma unroll
    for (int f = 0; f < 8; ++f) bfa[f] = *((const GAS bf16x8*)wlru + ((size_t)(wave * 8 + f)) * 64 + lane);
    float cba[2], cbx[2], clam[2];
#pragma unroll
    for (int nt = 0; nt < 2; ++nt) { const int gch = chb + 32 * nt + r32; cba[nt] = ba[gch]; cbx[nt] = bx[gch]; clam[nt] = lam[gch]; }
    asm volatile("s_waitcnt vmcnt(0) lgkmcnt(0)" ::: "memory");
    bf16x8 af[2][4];
#pragma unroll
    for (int ks = 0; ks < 4; ++ks) { const int cof = 16 * ks + 8 * hi;
        f32x4 w[4][2], bb[2];
#pragma unroll
        for (int tap = 0; tap < 4; ++tap) { w[tap][0] = *(const LAS f32x4*)(cwl + tap * 64 + cof); w[tap][1] = *(const LAS f32x4*)(cwl + tap * 64 + cof + 4); }
        bb[0] = *(const LAS f32x4*)(cwl + 256 + cof); bb[1] = *(const LAS f32x4*)(cwl + 256 + cof + 4);
#pragma unroll
        for (int mt = 0; mt < 2; ++mt) { const int tl = 32 * mt + r32;
            float a8[8];
#pragma unroll
            for (int e = 0; e < 8; ++e) a8[e] = bb[e >> 2][e & 3];
#pragma unroll
            for (int tap = 0; tap < 4; ++tap) { const v4u d = *(const LAS v4u*)(Lw + (tl + tap) * ROWB + cof * 2);
#pragma unroll
                for (int e = 0; e < 8; ++e) { const unsigned dw = d[e >> 1]; const float xv = __uint_as_float((e & 1) ? (dw & 0xffff0000u) : (dw << 16)); a8[e] += w[tap][e >> 2][e & 3] * xv; } }
            v4u pk; pk.x = pk2(a8[0], a8[1]); pk.y = pk2(a8[2], a8[3]); pk.z = pk2(a8[4], a8[5]); pk.w = pk2(a8[6], a8[7]);
            af[mt][ks] = __builtin_bit_cast(bf16x8, pk);
            asm volatile("s_waitcnt lgkmcnt(0)" ::: "memory");
            *(LAS v4u*)(Lw + tl * ROWB + cof * 2) = pk; }
    }
    f32x16 acc[2][2][2];
#pragma unroll
    for (int mat = 0; mat < 2; ++mat)
#pragma unroll
        for (int mt = 0; mt < 2; ++mt)
#pragma unroll
            for (int nt = 0; nt < 2; ++nt) acc[mat][mt][nt] = (f32x16){};
#pragma unroll
    for (int mat = 0; mat < 2; ++mat)
#pragma unroll
        for (int nt = 0; nt < 2; ++nt)
#pragma unroll
            for (int ks = 0; ks < 4; ++ks) { const bf16x8 bfr = (mat == 0) ? bfa[nt * 4 + ks] : *((const GAS bf16x8*)wlru + ((size_t)((mat * 8 + wave) * 8 + nt * 4 + ks)) * 64 + lane);
#pragma unroll
                for (int mt = 0; mt < 2; ++mt) acc[mat][mt][nt] = __builtin_amdgcn_mfma_f32_32x32x16_bf16(af[mt][ks], bfr, acc[mat][mt][nt], 0, 0, 0); }
    asm volatile("s_waitcnt lgkmcnt(0)" ::: "memory");
#pragma unroll
    for (int nt = 0; nt < 2; ++nt) { const int ch = 32 * nt + r32, gch = chb + ch;
        const float bav = cba[nt], bxv = cbx[nt]; const float nl = -clam[nt];
        const float k8 = -8.0f * 1.4426950408889634f * (fmaxf(nl, 0.f) + log1pf(expf(-fabsf(nl))));
#pragma unroll
        for (int mt = 0; mt < 2; ++mt)
#pragma unroll
            for (int r = 0; r < 16; ++r) { const int tl = 32 * mt + (r & 3) + 8 * (r >> 2) + 4 * hi;
                const float rec = bf2f(*(const LAS bf16_t*)(Lw + tl * ROWB + ch * 2));
                const float rg = fast_sigmoid(acc[0][mt][nt][r] + bav), ig = fast_sigmoid(acc[1][mt][nt][r] + bxv);
                const float a = __builtin_amdgcn_exp2f(k8 * rg);
                const float mult = __builtin_amdgcn_sqrtf(fmaxf(1.0f - a * a, 0.f));
                acc[0][mt][nt][r] = a; acc[1][mt][nt][r] = mult * ig * rec; }
        float gA[8], gH[8], pA[8], pH[8], myc[8], myp[8];
#pragma unroll
        for (int g = 0; g < 8; ++g) { const int mt = g >> 2, q4 = g & 3; float h = 0.f, p = 1.f;
#pragma unroll
            for (int i = 0; i < 4; ++i) { const float a = acc[0][mt][nt][4 * q4 + i]; h = a * h + acc[1][mt][nt][4 * q4 + i]; p *= a; }
            gA[g] = p; gH[g] = h; }
#pragma unroll
        for (int g = 0; g < 8; ++g) { pA[g] = __shfl_xor(gA[g], 32); pH[g] = __shfl_xor(gH[g], 32); }
        float cin = 0.f, pin = 1.f;
#pragma unroll
        for (int g = 0; g < 8; ++g) {
            const float A0 = hi ? pA[g] : gA[g], H0 = hi ? pH[g] : gH[g], A1 = hi ? gA[g] : pA[g], H1 = hi ? gH[g] : pH[g];
            const float cin1 = A0 * cin + H0, pin1 = A0 * pin;
            myc[g] = hi ? cin1 : cin; myp[g] = hi ? pin1 : pin;
            cin = A1 * cin1 + H1; pin = A1 * pin1; }
        if (hi == 0) { sumP[(size_t)item * 512 + gch] = pin; sumH[(size_t)item * 512 + gch] = cin; }
#pragma unroll
        for (int g = 0; g < 8; ++g) { const int mt = g >> 2, q4 = g & 3; float h = myc[g], p = myp[g];
#pragma unroll
            for (int i = 0; i < 4; ++i) { const int r = 4 * q4 + i; const float a = acc[0][mt][nt][r]; h = a * h + acc[1][mt][nt][r]; p = a * p; Hl[mt][nt][r] = h; Pc[mt][nt][r] = p; } }
    }
}
__device__ __forceinline__ void stage2(int item, int wave, int lane, LAS unsigned char* Lw, const bf16_t* gg, bf16_t* ao, const float* sumP, const float* sumH,
                                       const f32x16 (&Pc)[2][2], const f32x16 (&Hl)[2][2]) {
    const int b = item >> 6, c = item & 63, t0 = c * 64; const size_t n0 = (size_t)b * SEQ + t0;
    const int r32 = lane & 31, hi = lane >> 5, chb = wave * 64;
    float carry = 0.f;
    { const float* sp = sumP + (size_t)(b * 64) * 512 + chb + lane; const float* sh = sumH + (size_t)(b * 64) * 512 + chb + lane;
#pragma unroll 1
        for (int c0 = 0; c0 < c; c0 += 32) { float pv[32], hv[32];
#pragma unroll
            for (int i = 0; i < 32; ++i) { pv[i] = sp[(size_t)(c0 + i) * 512]; hv[i] = sh[(size_t)(c0 + i) * 512]; }
#pragma unroll
            for (int i = 0; i < 32; ++i) { const bool on = (c0 + i) < c; carry = on ? (pv[i] * carry + hv[i]) : carry; } } }
#pragma unroll
    for (int nt = 0; nt < 2; ++nt) { const int ch = 32 * nt + r32; const float cv = __shfl(carry, ch);
#pragma unroll
        for (int mt = 0; mt < 2; ++mt)
#pragma unroll
            for (int r = 0; r < 16; ++r) { const int tl = 32 * mt + (r & 3) + 8 * (r >> 2) + 4 * hi;
                *(LAS bf16_t*)(Lw + tl * ROWB + ch * 2) = f2bf(Hl[mt][nt][r] + Pc[mt][nt][r] * cv); } }
    asm volatile("s_waitcnt lgkmcnt(0)" ::: "memory");
#pragma unroll
    for (int pass = 0; pass < 8; ++pass) { const int row = pass * 8 + (lane >> 3), cof = 8 * (lane & 7);
        const v4u hv = *(const LAS v4u*)(Lw + row * ROWB + cof * 2); const v4u gv = *(const GAS v4u*)(gg + (n0 + row) * 512 + chb + cof);
        v4u o;
#pragma unroll
        for (int e = 0; e < 4; ++e) { const float h0 = __uint_as_float(hv[e] << 16), h1 = __uint_as_float(hv[e] & 0xffff0000u), g0 = __uint_as_float(gv[e] << 16), g1 = __uint_as_float(gv[e] & 0xffff0000u); o[e] = pk2(h0 * g0, h1 * g1); }
        *(GAS v4u*)(ao + (n0 + row) * 1024 + 512 + chb + cof) = o; }
    asm volatile("s_waitcnt lgkmcnt(0)" ::: "memory");
}
__device__ __forceinline__ void convert_item(int it, int lane, const float* wa, const float* wx, bf16_t* wlru) {
    const int mat = it >> 3, blk = it & 7, r32 = lane & 31, hi = lane >> 5; const float* W = (mat ? wx : wa) + (size_t)blk * 4096;
#pragma unroll
    for (int f = 0; f < 8; ++f) { const int nt = f >> 2, ks = f & 3; float v[8];
#pragma unroll
        for (int j = 0; j < 8; ++j) v[j] = W[(16 * ks + 8 * hi + j) * 64 + 32 * nt + r32];
        v4u o; o.x = pk2(v[0], v[1]); o.y = pk2(v[2], v[3]); o.z = pk2(v[4], v[5]); o.w = pk2(v[6], v[7]);
        *((GAS v4u*)wlru + ((size_t)(it * 8 + f)) * 64 + lane) = o; }
}
}
namespace moe {
constexpr int LCAP = 16384;
constexpr int AROW = 272, ABUF = 128 * AROW  , HROW = 528, META_OFF = 2 * ABUF  ;
typedef float f4_t __attribute__((ext_vector_type(4)));
__device__ __forceinline__ int crow(int r, int hi) { return (r & 3) + 8 * (r >> 2) + 4 * hi; }
__device__ __forceinline__ unsigned ld_u32_agent(const unsigned* p) { return __hip_atomic_load(p, __ATOMIC_RELAXED, __HIP_MEMORY_SCOPE_AGENT); }

typedef float f2_t __attribute__((ext_vector_type(2))); typedef __bf16 bf2_t __attribute__((ext_vector_type(2))); typedef unsigned long long u64;
constexpr float W1_SCALE = 64.0f, W2_SCALE = 32.0f;
__device__ __forceinline__ u64 pack_fp8x8(const float (&v)[8], float sc) {
    int lo = __builtin_amdgcn_cvt_pk_fp8_f32(v[0] * sc, v[1] * sc, 0, false); lo = __builtin_amdgcn_cvt_pk_fp8_f32(v[2] * sc, v[3] * sc, lo, true);
    int hi = __builtin_amdgcn_cvt_pk_fp8_f32(v[4] * sc, v[5] * sc, 0, false); hi = __builtin_amdgcn_cvt_pk_fp8_f32(v[6] * sc, v[7] * sc, hi, true);
    return (u64)(unsigned)lo | ((u64)(unsigned)hi << 32);
}
__device__ __forceinline__ bf16x8 fp8x8_to_bf16(unsigned lo_, unsigned hi_) {
    const int lo = (int)lo_, hi = (int)hi_;
    const f2_t a = __builtin_amdgcn_cvt_pk_f32_fp8(lo, false), b = __builtin_amdgcn_cvt_pk_f32_fp8(lo, true), c = __builtin_amdgcn_cvt_pk_f32_fp8(hi, false), d = __builtin_amdgcn_cvt_pk_f32_fp8(hi, true);
    v4u o; o.x = __builtin_bit_cast(unsigned, __builtin_convertvector(a, bf2_t)); o.y = __builtin_bit_cast(unsigned, __builtin_convertvector(b, bf2_t));
    o.z = __builtin_bit_cast(unsigned, __builtin_convertvector(c, bf2_t)); o.w = __builtin_bit_cast(unsigned, __builtin_convertvector(d, bf2_t));
    return __builtin_bit_cast(bf16x8, o);
}
__device__ __forceinline__ void pair8_from_kn(const float* W, int ldw, int ksp, int n0, GAS v4u* dst, int lane, const float* kgain, float sc) {
    const int r32 = lane & 31, hi = lane >> 5; float v[2][8];
#pragma unroll
    for (int h = 0; h < 2; ++h)
#pragma unroll
        for (int j = 0; j < 8; ++j) v[h][j] = W[(size_t)(32 * ksp + 16 * h + 8 * hi + j) * ldw + n0 + r32];
    if (kgain) {
#pragma unroll
        for (int h = 0; h < 2; ++h)
#pragma unroll
            for (int j = 0; j < 8; ++j) v[h][j] *= kgain[32 * ksp + 16 * h + 8 * hi + j]; }
    const u64 a = pack_fp8x8(v[0], sc), b = pack_fp8x8(v[1], sc);
    v4u o; o.x = (unsigned)a; o.y = (unsigned)(a >> 32); o.z = (unsigned)b; o.w = (unsigned)(b >> 32);
    dst[lane] = o;
}
__device__ __forceinline__ void frag_from_kn(const float* W, int ldw, int k0, int n0, GAS v4u* dst, int lane, const float* kgain) {
    const int r32 = lane & 31, hi = lane >> 5; float v[8];
#pragma unroll
    for (int j = 0; j < 8; ++j) v[j] = W[(size_t)(k0 + 8 * hi + j) * ldw + n0 + r32];
    if (kgain) {
#pragma unroll
        for (int j = 0; j < 8; ++j) v[j] *= kgain[k0 + 8 * hi + j]; }
    v4u o; o.x = pk2(v[0], v[1]); o.y = pk2(v[2], v[3]); o.z = pk2(v[4], v[5]); o.w = pk2(v[6], v[7]);
    dst[lane] = o;
}
constexpr int CONV_ITEMS = 4096 + 2048 + 128;
struct ConvP { const float* W; int ldw, ksp, n0; const float* gain; float sc; GAS v4u* dst; int dstride; };
__device__ __forceinline__ ConvP conv_decode(int it, const float* wgate, const float* wup, const float* wdown, const float* g2, bf16_t* w1f, bf16_t* w2f) {
    ConvP p;
    if (it < 4096) { const int e = it >> 7, gu = (it >> 6) & 1, fh = (it >> 5) & 1; p.ksp = it & 31; p.W = (gu ? wup : wgate) + (size_t)e * 1024 * 256; p.ldw = 256; p.n0 = 128 * fh; p.gain = g2; p.sc = W1_SCALE;
        p.dst = (GAS v4u*)w1f + ((size_t)((e * 16 + gu * 8 + 4 * fh) * 32 + p.ksp)) * 64; p.dstride = 32 * 64; }
    else { const int r = it - 4096, e = r >> 6, dq = r & 7; p.ksp = (r >> 3) & 7; p.W = wdown + (size_t)e * 256 * 1024; p.ldw = 1024; p.n0 = 128 * dq; p.gain = nullptr; p.sc = W2_SCALE;
        p.dst = (GAS v4u*)w2f + ((size_t)((e * 32 + 4 * dq) * 8 + p.ksp)) * 64; p.dstride = 8 * 64; }
    return p;
}
__device__ __forceinline__ void conv_load(const ConvP& p, int lane, f4_t (&v)[16]) {
    const int r32 = lane & 31, hi = lane >> 5;
#pragma unroll
    for (int i = 0; i < 16; ++i) v[i] = *(const GAS f4_t*)(p.W + (size_t)(32 * p.ksp + 2 * i + hi) * p.ldw + p.n0 + 4 * r32);
}
__device__ __forceinline__ void conv_finish(const ConvP& p, int lane, LAS unsigned* T, const f4_t (&v)[16]) {
    const int r32 = lane & 31, hi = lane >> 5;
#pragma unroll
    for (int i = 0; i < 16; ++i) { const float gk = p.gain ? p.gain[32 * p.ksp + 2 * i + hi] * p.sc : p.sc;
        int d = __builtin_amdgcn_cvt_pk_fp8_f32(v[i][0] * gk, v[i][1] * gk, 0, false); d = __builtin_amdgcn_cvt_pk_fp8_f32(v[i][2] * gk, v[i][3] * gk, d, true);
        T[(2 * i + hi) * 33 + r32] = (unsigned)d; }
    asm volatile("s_waitcnt lgkmcnt(0)" ::: "memory");
    const LAS unsigned char* Tb = (const LAS unsigned char*)T;
#pragma unroll
    for (int f = 0; f < 4; ++f) { unsigned w[4];
#pragma unroll
        for (int q = 0; q < 4; ++q) { const int rowb = 16 * (q >> 1) + 8 * hi + 4 * (q & 1); unsigned x = 0;
#pragma unroll
            for (int b = 0; b < 4; ++b) x |= (unsigned)Tb[(rowb + b) * 132 + 32 * f + r32] << (8 * b);
            w[q] = x; }
        p.dst[(size_t)f * p.dstride + lane] = (v4u){w[0], w[1], w[2], w[3]}; }
    asm volatile("s_waitcnt lgkmcnt(0)" ::: "memory");
}
__device__ __forceinline__ void convert_item(int it, int lane, LAS unsigned* T, const float* wgate, const float* wup, const float* wdown, const float* wgrp, const float* winner, const float* g2, bf16_t* w1f, bf16_t* w2f, bf16_t* wrf) {
    if (it < 6144) { const ConvP p = conv_decode(it, wgate, wup, wdown, g2, w1f, w2f); f4_t v[16]; conv_load(p, lane, v); conv_finish(p, lane, T, v);
    } else { const int r = it - 6144, nt = r >> 6, ks = r & 63, r32 = lane & 31, hi = lane >> 5, col = 32 * nt + r32; float v[8];
#pragma unroll
        for (int j = 0; j < 8; ++j) { const int k = 16 * ks + 8 * hi + j; float x = 0.f;
            if (col < 4) x = wgrp[k * 4 + col]; else if (col < 36) { const int g = (col - 4) >> 3, ee = (col - 4) & 7; x = winner[((size_t)g * 1024 + k) * 8 + ee]; }
            v[j] = x * g2[k]; }
        v4u o; o.x = pk2(v[0], v[1]); o.y = pk2(v[2], v[3]); o.z = pk2(v[4], v[5]); o.w = pk2(v[6], v[7]);
        ((GAS v4u*)wrf)[(size_t)r * 64 + lane] = o; }
}

__device__ __forceinline__ void route_block(int blk, int tid, int wave, int lane, LAS unsigned char* L, const bf16_t* xg, const bf16_t* wrf, const float* ssqp, const float* bg, const float* bi,
                                            unsigned* cnt, unsigned* lists, float* linv, float* lw) {
    const int r32 = lane & 31, hi = lane >> 5, tok0 = blk * 64;
    f32x16 acc[2][2];
#pragma unroll
    for (int mt = 0; mt < 2; ++mt)
#pragma unroll
        for (int nt = 0; nt < 2; ++nt) acc[mt][nt] = (f32x16){};
#pragma unroll
    for (int ksl = 0; ksl < 8; ++ksl) { const int ks = 8 * wave + ksl; bf16x8 a[2], bq[2];
#pragma unroll
        for (int mt = 0; mt < 2; ++mt) a[mt] = *(const GAS bf16x8*)(xg + (size_t)(tok0 + 32 * mt + r32) * 1024 + 16 * ks + 8 * hi);
#pragma unroll
        for (int nt = 0; nt < 2; ++nt) bq[nt] = *((const GAS bf16x8*)wrf + (size_t)(nt * 64 + ks) * 64 + lane);
#pragma unroll
        for (int mt = 0; mt < 2; ++mt)
#pragma unroll
            for (int nt = 0; nt < 2; ++nt) acc[mt][nt] = __builtin_amdgcn_mfma_f32_32x32x16_bf16(a[mt], bq[nt], acc[mt][nt], 0, 0, 0); }
    LAS float* slab = (LAS float*)L + wave * 64 * 40;
#pragma unroll
    for (int mt = 0; mt < 2; ++mt)
#pragma unroll
        for (int r = 0; r < 16; ++r) { const int tk = 32 * mt + crow(r, hi); slab[tk * 40 + r32] = acc[mt][0][r]; if (r32 < 4) slab[tk * 40 + 32 + r32] = acc[mt][1][r]; }
    LAS unsigned* lc = (LAS unsigned*)(L + 8 * 64 * 40 * 4);
    if (tid < 64) lc[tid] = 0u;
    __syncthreads();
    if (wave == 0) {
        const int tok = tok0 + lane; float lg[36];
#pragma unroll
        for (int j4 = 0; j4 < 9; ++j4) { f4_t s = (f4_t){0.f, 0.f, 0.f, 0.f};
#pragma unroll
            for (int w = 0; w < 8; ++w) s += *(const LAS f4_t*)((const LAS float*)L + (w * 64 + lane) * 40 + 4 * j4);
            lg[4 * j4] = s[0]; lg[4 * j4 + 1] = s[1]; lg[4 * j4 + 2] = s[2]; lg[4 * j4 + 3] = s[3]; }
        float ss = 0.f;
#pragma unroll
        for (int j = 0; j < 4; ++j) { const f4_t v = *(const GAS f4_t*)(ssqp + (size_t)tok * 16 + 4 * j); ss += (v[0] + v[1]) + (v[2] + v[3]); }
        const float inv = 1.0f / sqrtf(ss * (1.0f / 1024.0f) + 1e-6f);
        float gl[4];
#pragma unroll
        for (int g = 0; g < 4; ++g) gl[g] = lg[g] * inv + bg[g];
        int gi = 0; float gm = gl[0];
#pragma unroll
        for (int g = 1; g < 4; ++g) if (gl[g] > gm) { gm = gl[g]; gi = g; }
        float gs = 0.f;
#pragma unroll
        for (int g = 0; g < 4; ++g) gs += expf(gl[g] - gm);
        const float gw = 1.0f / gs;
        float il[8];
#pragma unroll
        for (int e = 0; e < 8; ++e) { float v = lg[4 + e]; float bb = bi[e];
#pragma unroll
            for (int g = 1; g < 4; ++g) { v = (gi == g) ? lg[4 + 8 * g + e] : v; bb = (gi == g) ? bi[8 * g + e] : bb; }
            il[e] = v * inv + bb; }
        int e1 = 0; float m1 = il[0];
#pragma unroll
        for (int e = 1; e < 8; ++e) if (il[e] > m1) { m1 = il[e]; e1 = e; }
        int e2 = 0; float m2 = -3.0e38f;
#pragma unroll
        for (int e = 0; e < 8; ++e) if (e != e1 && il[e] > m2) { m2 = il[e]; e2 = e; }
        const float p2 = expf(m2 - m1), w1 = 1.0f / (1.0f + p2), w2 = p2 / (1.0f + p2);
        const int ge1 = gi * 8 + e1, ge2 = gi * 8 + e2;
        const unsigned rk1 = __hip_atomic_fetch_add(&lc[ge1], 1u, __ATOMIC_RELAXED, __HIP_MEMORY_SCOPE_WORKGROUP);
        const unsigned rk2 = __hip_atomic_fetch_add(&lc[ge2], 1u, __ATOMIC_RELAXED, __HIP_MEMORY_SCOPE_WORKGROUP);
        asm volatile("s_waitcnt lgkmcnt(0)" ::: "memory");
        if (lane < 32) { const unsigned c = lc[lane]; unsigned base = 0u; if (c) base = __hip_atomic_fetch_add(cnt + lane, c, __ATOMIC_RELAXED, __HIP_MEMORY_SCOPE_AGENT); lc[32 + lane] = base; }
        asm volatile("s_waitcnt vmcnt(0) lgkmcnt(0)" ::: "memory");
        const unsigned p1 = lc[32 + ge1] + rk1, p2i = lc[32 + ge2] + rk2;
        lists[(size_t)ge1 * LCAP + p1] = (unsigned)tok * 2u; lists[(size_t)ge2 * LCAP + p2i] = (unsigned)tok * 2u + 1u;
        linv[(size_t)ge1 * LCAP + p1] = inv; linv[(size_t)ge2 * LCAP + p2i] = inv; lw[(size_t)ge1 * LCAP + p1] = gw * w1; lw[(size_t)ge2 * LCAP + p2i] = gw * w2;
    }
}

constexpr int YST_OFF = 71680, YROW = 144, YWAVE = 32 * YROW;
constexpr float Y_SCALE = 16.0f;
template <int NTC> __device__ __forceinline__ void moe_item(int e, int row_off, int R, int tid, int wave, int lane, LAS unsigned char* L, const bf16_t* xg, const bf16_t* w1f, const bf16_t* w2f,
                                         const unsigned* lists, const float* tokinv, const float* slotw, bf16_t* y) {
    lane = fresh_lane(); tid = wave * 64 + lane;
    const int r32 = lane & 31, hi = lane >> 5;
    constexpr int ntc = NTC;
    LAS unsigned* metaS = (LAS unsigned*)(L + META_OFF); LAS float* metaI = (LAS float*)(L + META_OFF + 512); LAS float* metaW = (LAS float*)(L + META_OFF + 1024);
    if (tid < 128) { const size_t li = (size_t)e * LCAP + row_off + (tid < R ? tid : 0); metaS[tid] = lists[li]; metaI[tid] = tokinv[li]; metaW[tid] = slotw[li]; }
    __syncthreads();
    const int srow = tid >> 4, c16 = tid & 15;
    v4u st[4];
#pragma unroll
    for (int p = 0; p < 4; ++p) st[p] = *(const GAS v4u*)(xg + (size_t)(metaS[srow + 32 * p] >> 1) * 1024 + c16 * 8);
#pragma unroll
    for (int p = 0; p < 4; ++p) *(LAS v4u*)(L + (srow + 32 * p) * AROW + c16 * 16) = st[p];
    f32x16 g[4], u[4];
#pragma unroll
    for (int nt = 0; nt < 4; ++nt) { g[nt] = (f32x16){}; u[nt] = (f32x16){}; }
    const GAS v4u* wgp = (const GAS v4u*)w1f + ((size_t)(e * 16 + wave) * 32) * 64 + lane;
    const GAS v4u* wup = (const GAS v4u*)w1f + ((size_t)(e * 16 + 8 + wave) * 32) * 64 + lane;
    v4u wgq[4], wuq[4];
#pragma unroll
    for (int s = 0; s < 4; ++s) { wgq[s] = wgp[s * 64]; wuq[s] = wup[s * 64]; }
    __syncthreads();
    bf16x8 tb[2][4];
    { const LAS unsigned char* ab = L + r32 * AROW + hi * 16;
#pragma unroll
        for (int nt = 0; nt < NTC; ++nt) tb[0][nt] = *(const LAS bf16x8*)(ab + nt * 32 * AROW); }
    for (int kc = 0; kc < 8; ++kc) {
        if (kc < 7) {
#pragma unroll
            for (int p = 0; p < 4; ++p) st[p] = *(const GAS v4u*)(xg + (size_t)(metaS[srow + 32 * p] >> 1) * 1024 + c16 * 8 + (kc + 1) * 128); }
        const LAS unsigned char* ab = L + (kc & 1) * ABUF + r32 * AROW + hi * 16;
#pragma unroll
        for (int ksl = 0; ksl < 8; ++ksl) { const int ks = kc * 8 + ksl, cur = ksl & 1; const v4u pg = wgq[ksl >> 1], pu = wuq[ksl >> 1];
            const bf16x8 wg = (ksl & 1) ? fp8x8_to_bf16(pg.z, pg.w) : fp8x8_to_bf16(pg.x, pg.y), wu = (ksl & 1) ? fp8x8_to_bf16(pu.z, pu.w) : fp8x8_to_bf16(pu.x, pu.y);
            if (ksl < 7) {
#pragma unroll
                for (int nt = 0; nt < NTC; ++nt) tb[cur ^ 1][nt] = *(const LAS bf16x8*)(ab + nt * 32 * AROW + (ksl + 1) * 32); }
            if ((ksl & 1) && (ks >> 1) + 4 < 32) { wgq[ksl >> 1] = wgp[(size_t)((ks >> 1) + 4) * 64]; wuq[ksl >> 1] = wup[(size_t)((ks >> 1) + 4) * 64]; }
#pragma unroll
            for (int nt = 0; nt < NTC; ++nt) {
                g[nt] = __builtin_amdgcn_mfma_f32_32x32x16_bf16(wg, tb[cur][nt], g[nt], 0, 0, 0); u[nt] = __builtin_amdgcn_mfma_f32_32x32x16_bf16(wu, tb[cur][nt], u[nt], 0, 0, 0); } }
        if (kc < 7) {
#pragma unroll
            for (int p = 0; p < 4; ++p) *(LAS v4u*)(L + ((kc + 1) & 1) * ABUF + (srow + 32 * p) * AROW + c16 * 16) = st[p]; }
        __syncthreads();
        if (kc < 7) { const LAS unsigned char* an = L + ((kc + 1) & 1) * ABUF + r32 * AROW + hi * 16;
#pragma unroll
            for (int nt = 0; nt < NTC; ++nt) tb[0][nt] = *(const LAS bf16x8*)(an + nt * 32 * AROW); }
    }
#pragma unroll
    for (int nt = 0; nt < NTC; ++nt) { const int tk = 32 * nt + r32; const float inv = metaI[tk] * (1.0f / W1_SCALE), wv = metaW[tk] * (1.0f / W2_SCALE);
#pragma unroll
        for (int q = 0; q < 4; ++q) { float h[4];
#pragma unroll
            for (int i = 0; i < 4; ++i) { const float gz = g[nt][4 * q + i] * inv, uz = u[nt][4 * q + i] * inv;
                h[i] = gz * __builtin_amdgcn_rcpf(1.0f + __builtin_amdgcn_exp2f(-1.4426950408889634f * gz)) * uz * wv; }
            const unsigned long long pk = (unsigned long long)pk2(h[0], h[1]) | ((unsigned long long)pk2(h[2], h[3]) << 32);
            *(LAS unsigned long long*)(L + tk * HROW + (32 * wave + 8 * q + 4 * hi) * 2) = pk; } }
    asm volatile("" ::: "memory");
    const int lane2 = fresh_lane();
    const GAS v4u* r0 = (const GAS v4u*)w2f + ((size_t)(e * 32 + 2 * wave) * 8) * 64 + lane2;
    const GAS v4u* r1 = r0 + 8 * 64;
    v4u q0[4], q1[4];
#pragma unroll
    for (int s = 0; s < 4; ++s) { q0[s] = *r0; q1[s] = *r1; r0 += 64; r1 += 64; }
    __syncthreads();
    LAS unsigned char* yst = L + YST_OFF + wave * YWAVE;
#pragma unroll 1
    for (int pass = 0; pass < 2; ++pass) { const int dtb = 16 * pass + 2 * wave;
        asm volatile("" ::: "memory");
        f32x16 ya[2][4];
#pragma unroll
        for (int d2 = 0; d2 < 2; ++d2)
#pragma unroll
            for (int nt = 0; nt < 4; ++nt) ya[d2][nt] = (f32x16){};
        const LAS unsigned char* hb = L + r32 * HROW + hi * 16;
#pragma unroll
        for (int nt = 0; nt < NTC; ++nt) tb[0][nt] = *(const LAS bf16x8*)(hb + nt * 32 * HROW);
#pragma unroll
        for (int ks = 0; ks < 16; ++ks) { const int cur = ks & 1; const v4u p0 = q0[(ks >> 1) & 3], p1 = q1[(ks >> 1) & 3];
            const bf16x8 a0 = (ks & 1) ? fp8x8_to_bf16(p0.z, p0.w) : fp8x8_to_bf16(p0.x, p0.y), a1 = (ks & 1) ? fp8x8_to_bf16(p1.z, p1.w) : fp8x8_to_bf16(p1.x, p1.y);
            if (ks < 15) {
#pragma unroll
                for (int nt = 0; nt < NTC; ++nt) tb[cur ^ 1][nt] = *(const LAS bf16x8*)(hb + nt * 32 * HROW + (ks + 1) * 32); }
            if (ks & 1) { const int ksp = ks >> 1;
                if (ksp == 4 && pass == 0) { r0 += 120 * 64; r1 += 120 * 64; }
                if (ksp < 4 || pass == 0) { q0[ksp & 3] = *r0; q1[ksp & 3] = *r1; r0 += 64; r1 += 64; } }
#pragma unroll
            for (int nt = 0; nt < NTC; ++nt) {
                ya[0][nt] = __builtin_amdgcn_mfma_f32_32x32x16_bf16(a0, tb[cur][nt], ya[0][nt], 0, 0, 0); ya[1][nt] = __builtin_amdgcn_mfma_f32_32x32x16_bf16(a1, tb[cur][nt], ya[1][nt], 0, 0, 0); } }
        const int lane3 = fresh_lane();
#pragma unroll
        for (int nt = 0; nt < NTC; ++nt) {
#pragma unroll
            for (int d2 = 0; d2 < 2; ++d2)
#pragma unroll
                for (int q = 0; q < 4; ++q) { int d = __builtin_amdgcn_cvt_pk_fp8_f32(ya[d2][nt][4 * q] * Y_SCALE, ya[d2][nt][4 * q + 1] * Y_SCALE, 0, false);
                    d = __builtin_amdgcn_cvt_pk_fp8_f32(ya[d2][nt][4 * q + 2] * Y_SCALE, ya[d2][nt][4 * q + 3] * Y_SCALE, d, true);
                    *(LAS unsigned*)(yst + r32 * 80 + 32 * d2 + 8 * q + 4 * hi) = (unsigned)d; }
            asm volatile("s_waitcnt lgkmcnt(0)" ::: "memory");
#pragma unroll
            for (int p = 0; p < 2; ++p) { const int row = p * 16 + (lane3 >> 2), ch = lane3 & 3, tk = 32 * nt + row; const v4u v = *(const LAS v4u*)(yst + row * 80 + ch * 16);
                if (tk < R) *(GAS v4u*)((unsigned char*)y + (size_t)metaS[tk] * 1024 + 32 * dtb + ch * 16) = v; }
            asm volatile("s_waitcnt lgkmcnt(0)" ::: "memory"); }
    }
    __syncthreads();
}
__device__ __forceinline__ void moe_phase(int vcu, int G, int tid, int wave, int lane, LAS unsigned char* L, const bf16_t* xg, const bf16_t* w1f, const bf16_t* w2f,
                                          const unsigned* cnt, const unsigned* lists, const float* tokinv, const float* slotw, bf16_t* y) {
    LAS int* sc = (LAS int*)(L + YST_OFF + 8 * YWAVE);
    if (tid < 32) sc[tid] = (int)ld_u32_agent(cnt + tid);
    __syncthreads();
    if (tid < 32) { const int c = sc[tid], r = c & 127; int pf = 0, rk = 0, F = 0, NR = 0;
        for (int k = 0; k < 32; ++k) { const int ck = sc[k], rk_ = ck & 127; if (k < tid) pf += ck >> 7; F += ck >> 7; NR += rk_ > 0; if (rk_ > r || (rk_ == r && k < tid)) rk += 1; }
        sc[32 + tid] = pf; sc[64 + tid] = r > 0 ? rk : 9999; if (tid == 0) { sc[96] = F; sc[97] = NR; } }
    __syncthreads();
    const int F = sc[96], M = F + sc[97];
    for (int r = 0;; ++r) {
        const int i = r * G + ((r & 1) ? (G - 1 - vcu) : vcu);
        if (i >= M) break;
        int e = 0, row_off = 0, R = 128;
        if (i < F) { for (int k = 1; k < 32; ++k) if (sc[32 + k] <= i) e = k; row_off = (i - sc[32 + e]) * 128; }
        else { const int rk = i - F; for (int k = 0; k < 32; ++k) if (sc[64 + k] == rk) e = k; row_off = (sc[e] >> 7) * 128; R = sc[e] & 127; }
        e = __builtin_amdgcn_readfirstlane(e); row_off = __builtin_amdgcn_readfirstlane(row_off); R = __builtin_amdgcn_readfirstlane(R);
        if (R > 96) moe_item<4>(e, row_off, R, tid, wave, lane, L, xg, w1f, w2f, lists, tokinv, slotw, y);
        else if (R > 64) moe_item<3>(e, row_off, R, tid, wave, lane, L, xg, w1f, w2f, lists, tokinv, slotw, y);
        else if (R > 32) moe_item<2>(e, row_off, R, tid, wave, lane, L, xg, w1f, w2f, lists, tokinv, slotw, y);
        else moe_item<1>(e, row_off, R, tid, wave, lane, L, xg, w1f, w2f, lists, tokinv, slotw, y);
    }
}
__device__ __forceinline__ void unpack4(unsigned long long a, float (&f)[4]) {
    f[0] = __uint_as_float((unsigned)a << 16); f[1] = __uint_as_float((unsigned)a & 0xffff0000u); f[2] = __uint_as_float((unsigned)(a >> 32) << 16); f[3] = __uint_as_float((unsigned)(a >> 32) & 0xffff0000u); }
template <int NR> __device__ __forceinline__ void final_rows(int m, int lane, const bf16_t* x1, const bf16_t* y, const float* fn, float* out) {
    typedef unsigned long long u64;
    u64 xa[NR][4]; unsigned ya[NR][4], yb[NR][4];
#pragma unroll
    for (int r = 0; r < NR; ++r) { const GAS u64* xr = (const GAS u64*)(x1 + (size_t)(m + r) * 1024) + lane; const GAS unsigned* y0 = (const GAS unsigned*)((const unsigned char*)y + (size_t)(2 * (m + r)) * 1024) + lane;
#pragma unroll
        for (int j = 0; j < 4; ++j) { xa[r][j] = xr[64 * j]; ya[r][j] = y0[64 * j]; yb[r][j] = y0[256 + 64 * j]; } }
    const GAS f4_t* gr = (const GAS f4_t*)fn + lane; f4_t gg[4];
#pragma unroll
    for (int j = 0; j < 4; ++j) gg[j] = gr[64 * j];
#pragma unroll
    for (int r = 0; r < NR; ++r) { f4_t v[4]; float s = 0.f;
#pragma unroll
        for (int j = 0; j < 4; ++j) { float a[4]; unpack4(xa[r][j], a);
            const f2_t b0 = __builtin_amdgcn_cvt_pk_f32_fp8((int)ya[r][j], false), b1 = __builtin_amdgcn_cvt_pk_f32_fp8((int)ya[r][j], true), c0 = __builtin_amdgcn_cvt_pk_f32_fp8((int)yb[r][j], false), c1 = __builtin_amdgcn_cvt_pk_f32_fp8((int)yb[r][j], true);
            v[j][0] = a[0] + (b0[0] + c0[0]) * (1.0f / Y_SCALE); v[j][1] = a[1] + (b0[1] + c0[1]) * (1.0f / Y_SCALE); v[j][2] = a[2] + (b1[0] + c1[0]) * (1.0f / Y_SCALE); v[j][3] = a[3] + (b1[1] + c1[1]) * (1.0f / Y_SCALE);
#pragma unroll
            for (int i = 0; i < 4; ++i) s += v[j][i] * v[j][i]; }
        const float inv = 1.0f / sqrtf(wave_sum(s) * (1.0f / 1024.0f) + 1e-6f);
        GAS f4_t* o = (GAS f4_t*)(out + (size_t)(m + r) * 1024) + lane;
#pragma unroll
        for (int j = 0; j < 4; ++j) o[64 * j] = v[j] * inv * gg[j]; }
}
}
struct Args { const float* in[21]; float* out; unsigned char* ws; int ph_lo, ph_hi, li, pad; };
__global__ void __launch_bounds__(512, 2) mega(Args args) {
    extern __shared__ __attribute__((aligned(16))) unsigned char lds[];
    const int tid = threadIdx.x, lane = tid & 63, wave = __builtin_amdgcn_readfirstlane(tid >> 6);
    const int G = gridDim.x, bx = blockIdx.x, vcu = (G % 8 == 0) ? (bx % 8) * (G / 8) + bx / 8 : bx;
    LAS unsigned char* L = (LAS unsigned char*)lds;
    for (int u = tid; u < (LDS_BYTES - LDSCTL_OFF) / 4; u += 512) ((LAS unsigned*)(L + LDSCTL_OFF))[u] = 0u;
    __syncthreads();
    unsigned char* ws = args.ws;
    unsigned* ctl = (unsigned*)(ws + WS_CTL);
    XcdBarrier bar = xcd_barrier_post(ctl + CW_BAR + args.li * XCD_BAR_WORDS, (volatile LAS unsigned*)(L + MISC_OFF) + 8);
    const int lo = args.ph_lo, hi = args.ph_hi;
#define IN(k) (lo <= (k) && (k) < hi)
#define BOTH(k) (IN(k) && IN((k) + 1))
    const float* x = args.in[0];
    bf16_t* Wt_in = (bf16_t*)(ws + WS_WIN); bf16_t* Wt_out = (bf16_t*)(ws + WS_WOUT);
    bf16_t* hn = (bf16_t*)(ws + WS_X1 + 32 * MiB);
    float* rowinv = (float*)(ws + WS_RT + 320 * 1024);
    const int gw = vcu * 8 + wave, NGW = G * 8;
    auto conv_slice = [&](int s) { if (G == 256 && wave <= 6) { const int ln = fresh_lane(); const int q = s * 768 + vcu * 3 + ((wave - 1) >> 1), h = (wave - 1) & 1;
            const int it = q < 2048 ? ((q >> 6) * 128 + ((q >> 5) & 1) * 64 + h * 32 + (q & 31)) : (4096 + 2 * (q - 2048) + h);
            const moe::ConvP p = moe::conv_decode(it, args.in[17], args.in[18], args.in[19], args.in[12], (bf16_t*)(ws + WS_W1F), (bf16_t*)(ws + WS_W2F));
            moe::f4_t v[16]; moe::conv_load(p, ln, v); moe::conv_finish(p, ln, (LAS unsigned*)(L + 84480 + wave * 4352), v); } };

    if (IN(0)) {
        LAS float* scr = (LAS float*)(L + wave * 16384);
        constexpr int I_IN = 88 * 16, I_OUT = 32 * 16;
        for (int it = gw; it < I_IN + I_OUT; it += NGW) {
            if (it < I_IN) { const int kb = it / 88, nb = it % 88, n0 = nb * 32;
                int src = n0, nv = 32; if (n0 >= 1536 && n0 < 2560) src = n0 + 8; else if (n0 == 2560) { src = 1536; nv = 8; } else if (n0 > 2560) { src = 0; nv = 0; }
                p0_transpose_item(args.in[2], DM, INC, src, nv, Wt_in, n0, kb * 64, scr, lane, args.in[1]); }
            else { const int r = it - I_IN, kb = r / 32, nb = r % 32;
                p0_transpose_item(args.in[11], DM, DM, nb * 32, 32, Wt_out, nb * 32, kb * 64, scr, lane, nullptr); }
        }
        for (int it = 6144 + gw; it < moe::CONV_ITEMS; it += NGW) moe::convert_item(it, lane, (LAS unsigned*)(L + 84480 + wave * 4352), args.in[17], args.in[18], args.in[19], args.in[13], args.in[15], args.in[12], (bf16_t*)(ws + WS_W1F), (bf16_t*)(ws + WS_W2F), (bf16_t*)(ws + WS_WR));
        for (int it = gw; it < 16; it += NGW) lru::convert_item(it, lane, args.in[6], args.in[8], (bf16_t*)(ws + WS_WLRU));
        for (int m = gw; m < NTOK; m += NGW) row_to_bf16_inv(x + (size_t)m * DM, hn + (size_t)m * DM, rowinv + m, lane);
        if (BOTH(0)) xcd_barrier_work(bar, wave, [&] { conv_slice(0); });
    }
    if (IN(1)) {
        pg8::Gemm g{hn, Wt_in, NTOK, NIN, DM}; pg8::StaticOrder S; S.init(NTOK, NIN, G, bx);
        pg8::EpiInProj E{(bf16_t*)(ws + WS_Q), (bf16_t*)(ws + WS_K), (bf16_t*)(ws + WS_V), (bf16_t*)(ws + WS_GG), (bf16_t*)(ws + WS_RI), (float*)(ws + WS_LF), args.in[3], rowinv};
        pg8::gemm_phase<pg8::EpiInProj, pg8::StaticOrder, true, true>(L, g, S, E);
        if (BOTH(1)) xcd_barrier_work(bar, wave, [&] { conv_slice(1); });
    }
    if (IN(2)) { const int lane = fresh_lane();
        f32x16 Pc[2][2], Hl[2][2];
        LAS unsigned char* Lw = L + wave * lru::WAVE_LDS;
        float* sumP = (float*)(ws + WS_SUM); float* sumH = sumP + 256 * 512;
        const bool act = bx < 256;
        if (act) lru::stage1(bx, wave, lane, Lw, (const bf16_t*)(ws + WS_RI), (const bf16_t*)(ws + WS_WLRU), args.in[4], args.in[5], args.in[7], args.in[9], args.in[10], sumP, sumH, Pc, Hl);
        xcd_barrier(bar);
        if (act) lru::stage2(bx, wave, lane, Lw, (const bf16_t*)(ws + WS_GG), (bf16_t*)(ws + WS_AO), sumP, sumH, Pc, Hl);
        __syncthreads();
    }
    if (IN(3)) {
        static_assert(attn_body::ATTN_LDS_BYTES <= LDSCTL_OFF, "attention LDS");
        const attn_body::AttnTensors AT{(const attn_body::bf16*)(ws + WS_Q), (const attn_body::bf16*)(ws + WS_K), (const attn_body::bf16*)(ws + WS_V), (attn_body::bf16*)(ws + WS_AO), (const float*)(ws + WS_LF)};
        const attn_body::StaticOrder S(G, bx);
        attn_body::attn_phase<attn_body::StaticOrder, 80>((char*)lds, AT, S);
        if (BOTH(3)) xcd_barrier_work(bar, wave, [&] { conv_slice(2); });
    }
    if (IN(4)) {
        pg8::Gemm g{(const bf16_t*)(ws + WS_AO), Wt_out, NTOK, DM, DM}; pg8::StaticOrder S; S.init(NTOK, DM, G, bx);
        pg8::EpiOutProj E{hn, (bf16_t*)(ws + WS_X1), (float*)(ws + WS_SSQP)};
        pg8::gemm_phase<pg8::EpiOutProj, pg8::StaticOrder, false, true>(L, g, S, E);
        if (BOTH(4)) xcd_barrier_work(bar, wave, [&] { conv_slice(3); });
    }
    unsigned* ecnt = ctl + CW_CNT; unsigned* lists = (unsigned*)(ws + WS_LIST); float* tokinv = (float*)(ws + 170 * MiB); float* slotw = (float*)(ws + 172 * MiB);
    if (IN(5)) { const int lane = fresh_lane(), tid = wave * 64 + lane;
        for (int blk = bx; blk < NTOK / 64; blk += G) { if (blk != bx) __syncthreads();
            moe::route_block(blk, tid, wave, lane, L, (const bf16_t*)(ws + WS_X1), (const bf16_t*)(ws + WS_WR), (const float*)(ws + WS_SSQP), args.in[14], args.in[16], ecnt, lists, tokinv, slotw); }
        if (G != 256) { for (int it = gw; it < 6144; it += NGW) moe::convert_item(it, lane, (LAS unsigned*)(L + 84480 + wave * 4352), args.in[17], args.in[18], args.in[19], args.in[13], args.in[15], args.in[12], (bf16_t*)(ws + WS_W1F), (bf16_t*)(ws + WS_W2F), (bf16_t*)(ws + WS_WR)); }
        if (BOTH(5)) xcd_barrier(bar);
    }
    if (IN(6)) { const int lane = fresh_lane(), tid = wave * 64 + lane;
        moe::moe_phase(vcu, G, tid, wave, lane, L, (const bf16_t*)(ws + WS_X1), (const bf16_t*)(ws + WS_W1F), (const bf16_t*)(ws + WS_W2F), ecnt, lists, tokinv, slotw, (bf16_t*)(ws + WS_Y));
        if (BOTH(6)) xcd_barrier(bar);
    }
    if (IN(7)) { const int lane = fresh_lane();
        for (int m = gw * 8; m < NTOK; m += NGW * 8) moe::final_rows<8>(m, lane, (const bf16_t*)(ws + WS_X1), (const bf16_t*)(ws + WS_Y), args.in[20], args.out);
    }
#undef IN
#undef BOTH
}
#ifndef PROBE_K
#define PROBE_K -1
#endif
#ifndef PROBE_FLAGS
#define PROBE_FLAGS 0
#endif
extern "C" void kernel_launch(void* const* d_in, const int* in_sizes, int n_in, void* d_out, int out_size, void* d_ws, size_t ws_size, hipStream_t stream) {
    static int grid = 0;
    if (grid == 0) {
        if (n_in != 21 || ws_size < WS_END) { fprintf(stderr, "kernel_launch: unexpected n_in %d / ws %zu\n", n_in, ws_size); grid = -1; return; }
        int dev = 0, cus = 0;
        if (hipGetDevice(&dev) != hipSuccess || hipDeviceGetAttribute(&cus, hipDeviceAttributeMultiprocessorCount, dev) != hipSuccess) { grid = -1; return; }
        if (hipFuncSetAttribute((const void*)mega, hipFuncAttributeMaxDynamicSharedMemorySize, LDS_BYTES) != hipSuccess) { grid = -1; return; }
        grid = cus;
    }
    if (grid < 0) return;
    (void)hipMemsetAsync((char*)d_ws + WS_CTL, 0, CTL_ZERO_BYTES, stream);
    Args a{};
    for (int i = 0; i < 21; ++i) a.in[i] = (const float*)d_in[i];
    a.out = (float*)d_out; a.ws = (unsigned char*)d_ws;
    unsigned char* ws = (unsigned char*)d_ws;
    if (PROBE_K >= 0) {
        a.ph_lo = 0; a.ph_hi = PROBE_K + 1; a.li = 0; a.pad = PROBE_FLAGS;
        hipLaunchKernelGGL(mega, dim3(grid), dim3(512), LDS_BYTES, stream, a);
        (void)hipMemsetAsync((char*)d_ws + WS_CTL, 0, CTL_ZERO_BYTES, stream);
    }
    a.ph_lo = 0; a.ph_hi = 8; a.li = 0; a.pad = 0;
    hipLaunchKernelGGL(mega, dim3(grid), dim3(512), LDS_BYTES, stream, a);
}
```

```cpp
#include <hip/hip_runtime.h>
#include <hip/hip_bf16.h>
#include <cstdio>
#include <cstdint>
#include <cmath>
namespace pg8 {
#define PG8_LAS __attribute__((address_space(3)))
typedef unsigned short bf16_t;
typedef short bf16x8 __attribute__((ext_vector_type(8)));
typedef float f32x4 __attribute__((ext_vector_type(4)));
typedef unsigned u32x4 __attribute__((ext_vector_type(4)));
constexpr int BM = 256, BK = 64, HALF = 128, HTB = HALF * BK * 2  , STAGE_BYTES = 8 * HTB, NXCD = 8, WGM = 8;

__host__ __device__ __forceinline__ int lds_byte(int r, int c) { const int st = (r >> 4) * 2 + (c >> 5), rr = r & 15, cc = c & 31, ob = rr * 64 + cc * 2; return st * 1024 + (ob ^ (((ob >> 9) & 1) << 5)); }
__host__ __device__ __forceinline__ void stage_rc(int b, int& R, int& C) { const int st = b / 1024, sb = b % 1024, swz = sb ^ (((sb >> 9) & 1) << 5); R = (st >> 1) * 16 + swz / 64; C = (st & 1) * 32 + (swz % 64) / 2; }
__host__ __device__ __forceinline__ int perm32(int rho) { const int n = rho >> 4, i = rho & 15; return 8 * (i >> 2) + 4 * n + (i & 3); }

struct Unit { int pm, pn; };
struct Gemm { const bf16_t* A; const bf16_t* Bt; int M, N, K; };

struct StaticOrder {
    int nM, nN, nwg, G, c;
    __host__ __device__ void init(int M, int N, int G_, int c_) { nM = M / BM; nN = N / BM; nwg = nM * nN; G = G_; c = c_; }
    __host__ __device__ bool next(int i, Unit& u) const {
        const long L = (long)i * G + c; if (L >= nwg) return false;
        int wgid = (int)L; { const int q = nwg / NXCD, r = nwg % NXCD, xcd = wgid % NXCD, off = wgid / NXCD; wgid = (xcd < r ? xcd * (q + 1) : r * (q + 1) + (xcd - r) * q) + off; }
        const int nig = WGM * nN, gid = wgid / nig, fm = gid * WGM, gsz = (nM - fm) < WGM ? (nM - fm) : WGM;
        u.pm = fm + ((wgid % nig) % gsz); u.pn = (wgid % nig) / gsz; return true;
    }
    __device__ __forceinline__ void a_ready(const Unit&) const {}
    __device__ __forceinline__ void done(const Unit&) const {}
};

__device__ __forceinline__ unsigned cvt_pk_bf16(float lo, float hi) { unsigned r; asm volatile("v_cvt_pk_bf16_f32 %0, %1, %2" : "=v"(r) : "v"(lo), "v"(hi)); return r; }
__device__ __forceinline__ float gelu_fast(float x) {
    const float t = x * (1.5957691216057308f + 0.07135481627260025f * x * x);
    return x * __builtin_amdgcn_rcpf(1.0f + __builtin_amdgcn_exp2f(-1.4426950408889634f * t));
}
struct EpiInProj {
    static constexpr bool PERM = true, AFTER_DRAIN = false;
    bf16_t *q, *k, *v, *gg, *ri; float* lf; const float* bfg; const float* rinv;
    __device__ __forceinline__ void operator()(const f32x4 (&acc)[2][2][4][2], const Unit& u, int wr, int wc, int fr, int fq) const {
        const int seg = u.pn >> 1;
        const int row0 = u.pm * BM + wr * 64 + fr;
        if (seg < 5) {
            bf16_t* base = seg == 0 ? q : seg == 1 ? k : seg == 2 ? v : seg == 3 ? gg : ri;
            const int col0 = (u.pn & 1) * 256 + wc * 32 + 8 * fq;
            float rvv[2][4];
#pragma unroll
            for (int ai = 0; ai < 2; ++ai)
#pragma unroll
                for (int m = 0; m < 4; ++m) rvv[ai][m] = rinv[row0 + ai * HALF + m * 16];
#pragma unroll
            for (int ai = 0; ai < 2; ++ai)
#pragma unroll
                for (int m = 0; m < 4; ++m) { bf16_t* rowp = base + (size_t)(row0 + ai * HALF + m * 16) * 512 + col0; const float rv = rvv[ai][m] * (seg == 0 ? 0.18033688011112042f : 1.0f);
#pragma unroll
                    for (int bj = 0; bj < 2; ++bj) { f32x4 v0 = acc[ai][bj][m][0] * rv, v1 = acc[ai][bj][m][1] * rv;
                        if (seg == 3) { v0 = (f32x4){gelu_fast(v0[0]), gelu_fast(v0[1]), gelu_fast(v0[2]), gelu_fast(v0[3])}; v1 = (f32x4){gelu_fast(v1[0]), gelu_fast(v1[1]), gelu_fast(v1[2]), gelu_fast(v1[3])}; }
                        u32x4 w; w.x = cvt_pk_bf16(v0[0], v0[1]); w.y = cvt_pk_bf16(v0[2], v0[3]); w.z = cvt_pk_bf16(v1[0], v1[1]); w.w = cvt_pk_bf16(v1[2], v1[3]);
                        *(u32x4*)(rowp + bj * HALF) = w; } }
        } else if (wc == 0) {
            if (fq == 0) {
                float bf8[8], rv[2][4];
#pragma unroll
                for (int h = 0; h < 8; ++h) bf8[h] = bfg[h];
#pragma unroll
                for (int ai = 0; ai < 2; ++ai)
#pragma unroll
                    for (int m = 0; m < 4; ++m) rv[ai][m] = rinv[row0 + ai * HALF + m * 16];
#pragma unroll
                for (int ai = 0; ai < 2; ++ai)
#pragma unroll
                    for (int m = 0; m < 4; ++m) { const int row = row0 + ai * HALF + m * 16; const int b = row >> 12, s = row & 4095;
#pragma unroll
                        for (int n = 0; n < 2; ++n)
#pragma unroll
                            for (int j = 0; j < 4; ++j) { const int h = 4 * n + j; const float z = acc[ai][0][m][n][j] * rv[ai][m] + bf8[h];
                                lf[((size_t)(b * 8 + h) << 12) + s] = fminf(z, 0.f) - 0.6931471805599453f * __builtin_amdgcn_logf(1.0f + __builtin_amdgcn_exp2f(-1.4426950408889634f * fabsf(z))); } }
            }
        }
    }
};
struct EpiOutProj {
    static constexpr bool PERM = true, AFTER_DRAIN = false;
    const bf16_t* x; bf16_t* x1; float* ssqp;
    __device__ __forceinline__ void operator()(const f32x4 (&acc)[2][2][4][2], const Unit& u, int wr, int wc, int fr, int fq) const {
        const int row0 = u.pm * BM + wr * 64 + fr, col0 = u.pn * BM + wc * 32 + 8 * fq;
        u32x4 xr[2][4][2];
#pragma unroll
        for (int ai = 0; ai < 2; ++ai)
#pragma unroll
            for (int m = 0; m < 4; ++m)
#pragma unroll
                for (int bj = 0; bj < 2; ++bj) xr[ai][m][bj] = *(const u32x4*)(x + (size_t)(row0 + ai * HALF + m * 16) * 1024 + col0 + bj * HALF);
#pragma unroll
        for (int ai = 0; ai < 2; ++ai)
#pragma unroll
            for (int m = 0; m < 4; ++m) { const int row = row0 + ai * HALF + m * 16; const size_t off = (size_t)row * 1024 + col0; float s = 0.f;
#pragma unroll
                for (int bj = 0; bj < 2; ++bj) { const u32x4 xw = xr[ai][m][bj];
                    const f32x4 xa = (f32x4){__uint_as_float(xw.x << 16), __uint_as_float(xw.x & 0xffff0000u), __uint_as_float(xw.y << 16), __uint_as_float(xw.y & 0xffff0000u)};
                    const f32x4 xb = (f32x4){__uint_as_float(xw.z << 16), __uint_as_float(xw.z & 0xffff0000u), __uint_as_float(xw.w << 16), __uint_as_float(xw.w & 0xffff0000u)};
                    const f32x4 o0 = xa + acc[ai][bj][m][0], o1 = xb + acc[ai][bj][m][1];
                    u32x4 w; w.x = cvt_pk_bf16(o0[0], o0[1]); w.y = cvt_pk_bf16(o0[2], o0[3]); w.z = cvt_pk_bf16(o1[0], o1[1]); w.w = cvt_pk_bf16(o1[2], o1[3]);
                    *(u32x4*)(x1 + off + bj * HALF) = w;
                    s += ((o0[0] * o0[0] + o0[1] * o0[1]) + (o0[2] * o0[2] + o0[3] * o0[3])) + ((o1[0] * o1[0] + o1[1] * o1[1]) + (o1[2] * o1[2] + o1[3] * o1[3])); }
                s += __shfl_xor(s, 16); s += __shfl_xor(s, 32);
                if (fq == 0) ssqp[(size_t)row * 16 + u.pn * 4 + wc] = s;
                if (m & 1) asm volatile("" ::: "memory"); }
    }
};
template <class Epi, class Sched, bool ALIGN_EPI = false, bool SP2 = false>
__device__ __forceinline__ void gemm_phase(PG8_LAS unsigned char* lds, const Gemm g, const Sched& S, const Epi& E) {
    const int tid = threadIdx.x, wid = __builtin_amdgcn_readfirstlane(tid >> 6), lane = tid & 63, wr = wid >> 2, wc = wid & 3, fr = lane & 15, fq = lane >> 4;
    const int K = g.K, nt = K / BK;
    unsigned voffA[2], voffB[2];
#pragma unroll
    for (int i = 0; i < 2; ++i) { int R, C; stage_rc(tid * 16 + i * 8192, R, C); const int Rb = Epi::PERM ? ((R & ~31) + perm32(R & 31)) : R;
        voffA[i] = (unsigned)(R * K + C) * 2u; voffB[i] = (unsigned)(Rb * K + C) * 2u; }
    const size_t kstep = (size_t)(BK * 2);
    const size_t hstep = (size_t)HALF * K * 2;
    const size_t tstep = 2 * hstep;
    const unsigned ldsw = (unsigned)wid * 1024u;
    const int aoff = lds_byte(wr * 64 + fr, fq * 8), boff = lds_byte(wc * 32 + fr, fq * 8);
#define PG8_SA(b, h) (((b) * 2 + (h)) * HTB)
#define PG8_SB(b, h) ((4 + (b) * 2 + (h)) * HTB)
#define PG8_STAGE(bufoff, gbase, voff) do { _Pragma("unroll") for (int _i = 0; _i < 2; ++_i) \
        __builtin_amdgcn_global_load_lds((const unsigned*)((const char*)(gbase) + (voff)[_i]), (PG8_LAS unsigned*)(lds + (bufoff) + ldsw + _i * 8192), 16, 0, 0); } while (0)
#define PG8_LDA(dst, b, h) do { _Pragma("unroll") for (int m = 0; m < 4; ++m) _Pragma("unroll") for (int k = 0; k < 2; ++k) dst[m][k] = *(const PG8_LAS bf16x8*)(lds + PG8_SA(b, h) + aoff + m * 2048 + k * 1024); } while (0)
#define PG8_LDB(dst, b, h) do { _Pragma("unroll") for (int n = 0; n < 2; ++n) _Pragma("unroll") for (int k = 0; k < 2; ++k) dst[n][k] = *(const PG8_LAS bf16x8*)(lds + PG8_SB(b, h) + boff + n * 2048 + k * 1024); } while (0)
#define PG8_MMA(ai, bj, At, Bt) do { __builtin_amdgcn_s_setprio(1); _Pragma("unroll") for (int m = 0; m < 4; ++m) _Pragma("unroll") for (int n = 0; n < 2; ++n) _Pragma("unroll") for (int k = 0; k < 2; ++k) \
        acc[ai][bj][m][n] = __builtin_amdgcn_mfma_f32_16x16x32_bf16(Bt[n][k], At[m][k], acc[ai][bj][m][n], 0, 0, 0); __builtin_amdgcn_s_setprio(0); } while (0)
#define PG8_WAIT_V(n) asm volatile("s_waitcnt vmcnt(" #n ")" ::: "memory")
#define PG8_WAIT_L(n) asm volatile("s_waitcnt lgkmcnt(" #n ")" ::: "memory")
#define PG8_BAR __builtin_amdgcn_s_barrier()
#define PG8_SCHED __builtin_amdgcn_sched_barrier(0)
    Unit cur, nxt; int ui = 0;
    if (!S.next(0, cur)) return;
    f32x4 acc[2][2][4][2];
#pragma unroll
    for (int a = 0; a < 2; ++a)
#pragma unroll
        for (int b = 0; b < 2; ++b)
#pragma unroll
            for (int m = 0; m < 4; ++m)
#pragma unroll
                for (int n = 0; n < 2; ++n) acc[a][b][m][n] = (f32x4){0.f, 0.f, 0.f, 0.f};
    bf16x8 At[4][2], B0[2][2], B1[2][2];
    const char* cA = (const char*)g.A + (size_t)cur.pm * tstep; const char* cB = (const char*)g.Bt + (size_t)cur.pn * tstep;
    S.a_ready(cur);
    if constexpr (SP2) {
        PG8_STAGE(PG8_SB(0, 0), cB, voffB); PG8_STAGE(PG8_SB(0, 1), cB + hstep, voffB); PG8_STAGE(PG8_SA(0, 0), cA, voffA); PG8_STAGE(PG8_SA(0, 1), cA + hstep, voffA);
        if (wr == 1) PG8_BAR;
        PG8_WAIT_V(2); PG8_BAR;
        PG8_STAGE(PG8_SB(1, 0), cB + kstep, voffB); PG8_STAGE(PG8_SA(1, 0), cA + kstep, voffA); PG8_STAGE(PG8_SB(1, 1), cB + hstep + kstep, voffB);
        PG8_WAIT_V(6); PG8_BAR;
    } else {
        PG8_STAGE(PG8_SB(0, 0), cB, voffB); PG8_STAGE(PG8_SA(0, 0), cA, voffA); PG8_STAGE(PG8_SB(0, 1), cB + hstep, voffB); PG8_STAGE(PG8_SA(0, 1), cA + hstep, voffA);
        if (wr == 1) PG8_BAR;
        PG8_WAIT_V(4); PG8_BAR;
        PG8_STAGE(PG8_SB(1, 0), cB + kstep, voffB); PG8_STAGE(PG8_SA(1, 0), cA + kstep, voffA); PG8_STAGE(PG8_SB(1, 1), cB + hstep + kstep, voffB);
        PG8_WAIT_V(6); PG8_BAR;
    }
    for (;;) {
        const bool has_next = S.next(ui + 1, nxt);
        const char* nA = has_next ? (const char*)g.A + (size_t)nxt.pm * tstep : cA; const char* nB = has_next ? (const char*)g.Bt + (size_t)nxt.pn * tstep : cB;
        for (int t = 0; t < nt; t += 2) {
            const bool last = (t == nt - 2);
            const char* a1 = cA + (size_t)(t + 1) * kstep;
            const char* a2 = last ? nA : cA + (size_t)(t + 2) * kstep; const char* b2 = last ? nB : cB + (size_t)(t + 2) * kstep;
            const char* a3 = a2 + kstep; const char* b3 = b2 + kstep;
            if (last && has_next) S.a_ready(nxt);
            if constexpr (SP2) {
            PG8_LDB(B0, 0, 0); PG8_LDB(B1, 0, 1); PG8_SCHED; PG8_LDA(At, 0, 0); PG8_STAGE(PG8_SA(1, 1), a1 + hstep, voffA);
            PG8_WAIT_V(8); PG8_WAIT_L(0); PG8_BAR; PG8_MMA(0, 0, At, B0); PG8_MMA(0, 1, At, B1); PG8_BAR; PG8_SCHED;
            PG8_LDA(At, 0, 1); PG8_STAGE(PG8_SB(0, 0), b2, voffB); PG8_STAGE(PG8_SB(0, 1), b2 + hstep, voffB); PG8_STAGE(PG8_SA(0, 0), a2, voffA);
            PG8_WAIT_V(8); PG8_WAIT_L(0); PG8_BAR; PG8_MMA(1, 0, At, B0); PG8_MMA(1, 1, At, B1); PG8_BAR; PG8_SCHED;
            PG8_LDB(B0, 1, 0); PG8_LDB(B1, 1, 1); PG8_SCHED; PG8_LDA(At, 1, 0); PG8_STAGE(PG8_SA(0, 1), a2 + hstep, voffA);
            PG8_WAIT_V(8); PG8_WAIT_L(0); PG8_BAR; PG8_MMA(0, 0, At, B0); PG8_MMA(0, 1, At, B1); PG8_BAR; PG8_SCHED;
            PG8_LDA(At, 1, 1); PG8_STAGE(PG8_SB(1, 0), b3, voffB); PG8_STAGE(PG8_SB(1, 1), b3 + hstep, voffB); PG8_STAGE(PG8_SA(1, 0), a3, voffA);
            PG8_WAIT_V(8); PG8_WAIT_L(0); PG8_BAR; PG8_MMA(1, 0, At, B0); PG8_MMA(1, 1, At, B1); PG8_BAR; PG8_SCHED;
            } else {
            PG8_LDB(B0, 0, 0); PG8_SCHED; PG8_LDA(At, 0, 0); PG8_STAGE(PG8_SA(1, 1), a1 + hstep, voffA);
            PG8_WAIT_L(8); PG8_BAR; PG8_WAIT_L(0); PG8_MMA(0, 0, At, B0); PG8_BAR; PG8_SCHED;
            PG8_LDB(B1, 0, 1); PG8_STAGE(PG8_SB(0, 0), b2, voffB);
            PG8_BAR; PG8_WAIT_L(0); PG8_MMA(0, 1, At, B1); PG8_BAR;
            PG8_LDA(At, 0, 1); PG8_STAGE(PG8_SA(0, 0), a2, voffA);
            PG8_BAR; PG8_WAIT_L(0); PG8_MMA(1, 0, At, B0); PG8_BAR; PG8_SCHED;
            PG8_STAGE(PG8_SB(0, 1), b2 + hstep, voffB);
            PG8_WAIT_V(6); PG8_BAR; PG8_MMA(1, 1, At, B1); PG8_BAR;
            PG8_LDB(B0, 1, 0); PG8_SCHED; PG8_LDA(At, 1, 0); PG8_STAGE(PG8_SA(0, 1), a2 + hstep, voffA);
            PG8_WAIT_L(8); PG8_BAR; PG8_WAIT_L(0); PG8_MMA(0, 0, At, B0); PG8_BAR; PG8_SCHED;
            PG8_LDB(B1, 1, 1); PG8_STAGE(PG8_SB(1, 0), b3, voffB);
            PG8_BAR; PG8_WAIT_L(0); PG8_MMA(0, 1, At, B1); PG8_BAR;
            PG8_LDA(At, 1, 1); PG8_STAGE(PG8_SA(1, 0), a3, voffA);
            PG8_BAR; PG8_WAIT_L(0); PG8_MMA(1, 0, At, B0); PG8_BAR; PG8_SCHED;
            PG8_STAGE(PG8_SB(1, 1), b3 + hstep, voffB);
            PG8_WAIT_V(6); PG8_BAR; PG8_MMA(1, 1, At, B1); PG8_BAR;
            }
        }
        if constexpr (ALIGN_EPI) { if (wr == 0) PG8_BAR; }
        if constexpr (!Epi::AFTER_DRAIN) { E(acc, cur, wr, wc, fr, fq); S.done(cur); }
        if (!has_next) break;
#pragma unroll
        for (int a = 0; a < 2; ++a)
#pragma unroll
            for (int b = 0; b < 2; ++b)
#pragma unroll
                for (int m = 0; m < 4; ++m)
#pragma unroll
                    for (int n = 0; n < 2; ++n) acc[a][b][m][n] = (f32x4){0.f, 0.f, 0.f, 0.f};
        cur = nxt; cA = nA; cB = nB; ++ui;
        if constexpr (ALIGN_EPI) { if (wr == 1) PG8_BAR; }
    }
    PG8_WAIT_V(0);
    if constexpr (!ALIGN_EPI) { if (wr == 0) PG8_BAR; }
    PG8_BAR;
    if constexpr (Epi::AFTER_DRAIN) { E.fused(acc, cur, wr, wc, fr, fq, lds, wid, lane); S.done(cur); }
#undef PG8_SA
#undef PG8_SB
#undef PG8_STAGE
#undef PG8_LDA
#undef PG8_LDB
#undef PG8_MMA
#undef PG8_WAIT_V
#undef PG8_WAIT_L
#undef PG8_BAR
#undef PG8_SCHED
}
}
#define GAS __attribute__((address_space(1)))
#define LAS __attribute__((address_space(3)))
typedef unsigned short bf16_t;
typedef unsigned v4u __attribute__((ext_vector_type(4)));
typedef float f32x4 __attribute__((ext_vector_type(4)));
typedef float f32x16 __attribute__((ext_vector_type(16)));
typedef short bf16x8 __attribute__((ext_vector_type(8)));
#define LDS_WAIT() asm volatile("s_waitcnt lgkmcnt(0)" ::: "memory")
#define VM_WAIT() asm volatile("s_waitcnt vmcnt(0)" ::: "memory")
__device__ __forceinline__ unsigned f2bfu(float f) { unsigned u = __builtin_bit_cast(unsigned, f); return (u + 0x7fffu + ((u >> 16) & 1u)) >> 16; }
__device__ __forceinline__ unsigned pk2(float lo, float hi) { return f2bfu(lo) | (f2bfu(hi) << 16); }
__device__ __forceinline__ float bf2f(bf16_t v) { return __uint_as_float(((unsigned)v) << 16); }
__device__ __forceinline__ bf16_t f2bf(float f) { return (bf16_t)f2bfu(f); }
__device__ __forceinline__ int fresh_lane() { int l; asm volatile("v_mbcnt_lo_u32_b32 %0, -1, 0\n\tv_mbcnt_hi_u32_b32 %0, -1, %0" : "=v"(l)); return l; }
__device__ __forceinline__ float wave_sum(float v) {
#pragma unroll
    for (int o = 1; o < 64; o <<= 1) v += __shfl_xor(v, o);
    return v;
}
constexpr int NTOK = 16384, SEQ = 4096, DM = 1024, NB = 4, NH = 8, INC = 2568, NIN = 2816;
constexpr float LOG2E = 1.4426950408889634f;
constexpr size_t MiB = 1u << 20;
constexpr size_t WS_CTL = 0, CTL_ZERO_BYTES = 1 * MiB;
constexpr size_t WS_WIN = 1 * MiB;
constexpr size_t WS_WOUT = 7 * MiB;
constexpr size_t WS_W1F = 9 * MiB;
constexpr size_t WS_W2F = 41 * MiB;
constexpr size_t WS_WLRU = 57 * MiB;
constexpr size_t WS_WR = 57 * MiB + 512 * 1024;
constexpr size_t WS_HN = 58 * MiB;
constexpr size_t WS_AO = WS_HN;
constexpr size_t WS_Q = 90 * MiB, WS_K = 106 * MiB, WS_V = 122 * MiB, WS_GG = 138 * MiB, WS_RI = 154 * MiB;
constexpr size_t WS_XG = 90 * MiB;
constexpr size_t WS_Y = 122 * MiB;
constexpr size_t WS_X1 = 186 * MiB;
constexpr size_t WS_LF = 250 * MiB;
constexpr size_t WS_C2 = 250 * MiB + 512 * 1024;
constexpr size_t WS_SSQP = 251 * MiB;
constexpr size_t WS_RT = 252 * MiB;
constexpr size_t WS_SUM = 252 * MiB + 512 * 1024;
constexpr size_t WS_LIST = 253 * MiB + 512 * 1024;
constexpr size_t WS_END = 256 * MiB;
constexpr int CW_BAR = 4096;
constexpr int CW_CNT = 32768;
constexpr int RING_BYTES = 131072, LDS_BYTES = 147456, MISC_OFF = LDS_BYTES - 512, LDSCTL_OFF = LDS_BYTES - 1024;
#define XB_TMO      128
#define XB_XCNT(j)  (256  + 64 * (j))
#define XB_XSUB(j)  (1280 + 64 * (j))
#define XB_XGEN(j)  (2304 + 64 * (j))
#define XB_TOP      3328
#define XB_TOPGEN   3392
#define XCD_BAR_WORDS 3456
#define XB_SPIN_CAP (1u << 18)

__device__ __forceinline__ unsigned xb_ld(unsigned* p)              { return __hip_atomic_load(p, __ATOMIC_RELAXED, __HIP_MEMORY_SCOPE_AGENT); }
__device__ __forceinline__ unsigned xb_add(unsigned* p, unsigned v) { return __hip_atomic_fetch_add(p, v, __ATOMIC_RELAXED, __HIP_MEMORY_SCOPE_AGENT); }
__device__ __forceinline__ unsigned xb_xcc_id() { return (unsigned)__builtin_amdgcn_s_getreg((3 << 11) | 20) & 0xFu; }
#define XB_SPIN(cond, bar) do { unsigned _sp = 0; while (cond) { __builtin_amdgcn_s_sleep(1); \
    if ((++_sp & 255u) == 0u) { if (xb_ld(&(bar)[XB_TMO])) break; if (_sp > XB_SPIN_CAP) { atomicAdd(&(bar)[XB_TMO], 1u); break; } } } } while (0)

struct XcdBarrier {
    unsigned* bar; unsigned x;
    volatile LAS unsigned* st;
};

__device__ __forceinline__ XcdBarrier xcd_barrier_post(unsigned* bar, volatile LAS unsigned* st) {
    XcdBarrier b; b.bar = bar; b.x = xb_xcc_id(); b.st = st;
    if (threadIdx.x == 0) (void)xb_add(&bar[XB_XCNT(b.x)], 1u);
    return b;
}
__device__ __forceinline__ void xcd_barrier_complete(unsigned* bar, unsigned x, unsigned& nloc, unsigned& nx) {
    const unsigned G = gridDim.x * gridDim.y * gridDim.z;
    unsigned sum, cnt, mine, sp = 0u;
    for (;;) {
        sum = 0u; cnt = 0u; mine = 0u;
#pragma unroll
        for (unsigned j = 0; j < 16; ++j) { const unsigned c = xb_ld(&bar[XB_XCNT(j)]); sum += c; cnt += (c > 0u) ? 1u : 0u; mine = (j == x) ? c : mine; }
        if (sum == G) break;
        __builtin_amdgcn_s_sleep(1);
        if ((++sp & 255u) == 0u) { if (xb_ld(&bar[XB_TMO])) break; if (sp > XB_SPIN_CAP) { atomicAdd(&bar[XB_TMO], 1u); break; } }
    }
    nloc = mine > 0u ? mine : 1u; nx = cnt > 0u ? cnt : 1u;
}

__device__ __forceinline__ void xcd_barrier_thread0(const XcdBarrier& b) {
        unsigned* bar = b.bar;
        __builtin_amdgcn_s_waitcnt(0);
        unsigned nloc = b.st[0], nx = b.st[1];
        if (nloc == 0u) { xcd_barrier_complete(bar, b.x, nloc, nx); b.st[0] = nloc; b.st[1] = nx; }
        const unsigned old = xb_add(&bar[XB_XSUB(b.x)], 1u);
        const unsigned gen = old / nloc;
        if (old + 1u == (gen + 1u) * nloc) {
            __builtin_amdgcn_fence(__ATOMIC_RELEASE, "agent");
            asm volatile("s_waitcnt vmcnt(0)" ::: "memory");
            const unsigned og = xb_add(&bar[XB_TOP], 1u);
            const unsigned tg = og / nx;
            if (og + 1u == (tg + 1u) * nx) xb_add(&bar[XB_TOPGEN], 1u);
            else XB_SPIN(xb_ld(&bar[XB_TOPGEN]) == tg, bar);
            __builtin_amdgcn_fence(__ATOMIC_ACQUIRE, "agent");
            xb_add(&bar[XB_XGEN(b.x)], 1u);
            asm volatile("s_waitcnt vmcnt(0)" ::: "memory");
        } else {
            XB_SPIN(xb_ld(&bar[XB_XGEN(b.x)]) == gen, bar);
            __builtin_amdgcn_fence(__ATOMIC_ACQUIRE, "agent");
            asm volatile("s_waitcnt vmcnt(0)" ::: "memory");
        }
}
__device__ __forceinline__ void xcd_barrier(const XcdBarrier& b) {
    asm volatile("s_waitcnt vmcnt(0)" ::: "memory");
    __syncthreads();
    if (threadIdx.x == 0) xcd_barrier_thread0(b);
    __syncthreads();
}
template <class F> __device__ __forceinline__ void xcd_barrier_work(const XcdBarrier& b, int wave, F work) {
    asm volatile("s_waitcnt vmcnt(0)" ::: "memory");
    __syncthreads();
    if (wave == 0) { if (threadIdx.x == 0) xcd_barrier_thread0(b); }
    else work();
    __syncthreads();
}
#include <hip/hip_bf16.h>
namespace attn_body {
using bf16=__hip_bfloat16;
using bf16x8=__attribute__((ext_vector_type(8)))short;
using s16x4=__attribute__((ext_vector_type(4)))short;
using f32x16=__attribute__((ext_vector_type(16)))float;
using u32x4=__attribute__((ext_vector_type(4)))unsigned;
using u32x2=__attribute__((ext_vector_type(2)))unsigned;
constexpr int BATCH=4,NHEAD=8,SEQ=4096,D=64,DM=NHEAD*D,OPITCH=1024;
constexpr int NW=8,QBLK=32,QB=QBLK*NW,KVBLK=64,NQB=SEQ/QB;
constexpr int ATTN_PITCH=DM, ATTN_UNIT_ROWS=QB;
__device__ __forceinline__ int crow(int r,int hi){return (r&3)+8*(r>>2)+4*hi;}
#define SBAR() __builtin_amdgcn_sched_barrier(0)
__device__ __forceinline__ void cmask(f32x16&p0,f32x16&p1,int jb,int qrel,int hi){
  const float NEG=-INFINITY; int kb=64*jb+4*hi;
  #pragma unroll
  for(int r=0;r<16;++r){int kv=kb+(r&3)+8*(r>>2); if(kv>qrel)p0[r]=NEG; if(kv+32>qrel)p1[r]=NEG;}
}

constexpr int NSLOT=3, SLOTB=8192;
constexpr int LDS_K=0, LDS_V=NSLOT*SLOTB, LDS_WS=2*NSLOT*SLOTB, LDS_OST=LDS_WS+NW*64*4, LDS_BYTES=LDS_OST+NW*4096; constexpr int LDS_CK=LDS_BYTES, LDS_CKW=LDS_CK+SEQ*4, LDS_KA=LDS_CKW+64, LDS_TOTAL=LDS_KA+SEQ*8;
constexpr float C2=0.125f*1.4426950408889634f;
__device__ __forceinline__ void glds16(const void*gsrc,unsigned lds_dst){unsigned keep;
  asm volatile("s_mov_b32 %0, m0\n\ts_mov_b32 m0, %2\n\ts_nop 0\n\tglobal_load_lds_dwordx4 %1, off\n\ts_mov_b32 m0, %0":"=&s"(keep):"v"(gsrc),"s"(lds_dst):"memory");}
__device__ __forceinline__ float max3f(float a,float b,float c){float r;asm("v_max3_f32 %0, %1, %2, %3":"=v"(r):"v"(a),"v"(b),"v"(c));return r;}
__device__ __forceinline__ float max2f(float a,float b){float r;asm("v_max_f32_e32 %0, %1, %2":"=v"(r):"v"(a),"v"(b));return r;}
__device__ __forceinline__ float fadd_s(float a,float b){float r;asm("v_add_f32_e32 %0, %1, %2":"=v"(r):"v"(a),"v"(b));return r;}
__device__ __forceinline__ float fsub_s(float a,float b){float r;asm("v_sub_f32_e32 %0, %1, %2":"=v"(r):"v"(a),"v"(b));return r;}
typedef float f32x2_t __attribute__((ext_vector_type(2))); typedef __bf16 bf16x2_t __attribute__((ext_vector_type(2)));
__device__ __forceinline__ unsigned cvtpk_s(float lo,float hi){f32x2_t v={lo,hi};bf16x2_t b=__builtin_convertvector(v,bf16x2_t);return __builtin_bit_cast(unsigned,b);}
#define WAIT_BAR(N) asm volatile("s_waitcnt vmcnt(" #N ") lgkmcnt(0)\n\ts_barrier":::"memory")

__device__ __forceinline__ void qkt(f32x16&p0,f32x16&p1,const char*Kslot,const bf16x8*qr,int r32,int hi){
  const char*kb=Kslot+hi*1024+r32*16;
  #pragma unroll
  for(int d0=0;d0<4;++d0){
    const bf16x8 b0=*reinterpret_cast<const bf16x8*>(kb+d0*2048);
    const bf16x8 b1=*reinterpret_cast<const bf16x8*>(kb+d0*2048+512);
    p0=__builtin_amdgcn_mfma_f32_32x32x16_bf16(b0,qr[d0],p0,0,0,0);p1=__builtin_amdgcn_mfma_f32_32x32x16_bf16(b1,qr[d0],p1,0,0,0);}
}
typedef __attribute__((address_space(3))) const char* lds_cptr;
typedef short v4i16_t __attribute__((ext_vector_type(4)));
__device__ __forceinline__ void kload8(bf16x8*kf,lds_cptr kp){
  kf[0]=*(const __attribute__((address_space(3))) bf16x8*)(kp);      kf[1]=*(const __attribute__((address_space(3))) bf16x8*)(kp+512);
  kf[2]=*(const __attribute__((address_space(3))) bf16x8*)(kp+2048); kf[3]=*(const __attribute__((address_space(3))) bf16x8*)(kp+2560);
  kf[4]=*(const __attribute__((address_space(3))) bf16x8*)(kp+4096); kf[5]=*(const __attribute__((address_space(3))) bf16x8*)(kp+4608);
  kf[6]=*(const __attribute__((address_space(3))) bf16x8*)(kp+6144); kf[7]=*(const __attribute__((address_space(3))) bf16x8*)(kp+6656);
}
__device__ __forceinline__ void kload2(bf16x8*kf,lds_cptr kp,int j){ kf[2*j]=*(const __attribute__((address_space(3))) bf16x8*)(kp+j*2048); kf[2*j+1]=*(const __attribute__((address_space(3))) bf16x8*)(kp+j*2048+512); }
__device__ __forceinline__ s16x4 vtr(lds_cptr p){ return __builtin_bit_cast(s16x4,__builtin_amdgcn_ds_read_tr16_b64_v4i16((__attribute__((address_space(3))) v4i16_t*)p)); }
__device__ __forceinline__ float rowmax(const f32x16&p0,const f32x16&p1){
  float a=max3f(p0[0],p0[1],p1[0]),b=max3f(p0[2],p0[3],p1[1]);a=max3f(a,p1[2],p1[3]);
  #pragma unroll
  for(int r=4;r<16;r+=4){a=max3f(a,p0[r],p0[r+1]);b=max3f(b,p0[r+2],p0[r+3]);a=max3f(a,p1[r],p1[r+1]);b=max3f(b,p1[r+2],p1[r+3]);}
  const float m=max2f(a,b);
  auto rr=__builtin_amdgcn_permlane32_swap(__float_as_uint(m),__float_as_uint(m),false,false);
  return max2f(__uint_as_float(rr[0]),__uint_as_float(rr[1]));
}
__device__ __forceinline__ void pv(f32x16*o,int vb,bf16x8 pa0,bf16x8 pa1,bf16x8 pa2,bf16x8 pa3){
  #pragma unroll
  for(int d0=0;d0<2;++d0){s16x4 lo[4],hi[4];
    #pragma unroll
    for(int ks=0;ks<4;++ks){
      asm volatile("ds_read_b64_tr_b16 %0,%1 offset:%c2":"=&v"(lo[ks]):"v"(vb),"i"(d0*4096+ks*1024):"memory");
      asm volatile("ds_read_b64_tr_b16 %0,%1 offset:%c2":"=&v"(hi[ks]):"v"(vb),"i"(d0*4096+ks*1024+512):"memory");}
    asm volatile("s_waitcnt lgkmcnt(0)":::"memory");SBAR();
    #define PK(k) (bf16x8){lo[k][0],lo[k][1],lo[k][2],lo[k][3],hi[k][0],hi[k][1],hi[k][2],hi[k][3]}
    o[d0]=__builtin_amdgcn_mfma_f32_32x32x16_bf16(pa0,PK(0),o[d0],0,0,0);
    o[d0]=__builtin_amdgcn_mfma_f32_32x32x16_bf16(pa1,PK(1),o[d0],0,0,0);
    o[d0]=__builtin_amdgcn_mfma_f32_32x32x16_bf16(pa2,PK(2),o[d0],0,0,0);
    o[d0]=__builtin_amdgcn_mfma_f32_32x32x16_bf16(pa3,PK(3),o[d0],0,0,0);
    #undef PK
  }
}

#ifndef ATTN_STORE16
#define ATTN_STORE16(p,v) (*(u32x4*)(p)=(v))
#endif
template<int THRL> __device__ __forceinline__ void attn_unit(int b,int h,int qb,const bf16*Q,const bf16*__restrict__ K,const bf16*__restrict__ V,bf16*O,const float*LF,char*shm,bool build_ck){
  const int tid=threadIdx.x,lane=tid&63,r32=lane&31,hi=lane>>5; const int wid=__builtin_amdgcn_readfirstlane(tid>>6);
  const long rowbase=(long)b*SEQ; const int q0=qb*QB;
  const bf16*Qw=Q+(rowbase+q0+wid*QBLK)*DM+h*D;
  const bf16*Kh=K+rowbase*DM+h*D,*Vh=V+rowbase*DM+h*D;
  const unsigned lds0=(unsigned)(uintptr_t)shm;
  float*wsf=(float*)(shm+LDS_WS)+wid*64;
  const bf16*ksrc=Kh+(long)lane*DM+wid*8;
  const bf16*vsrc=Vh+(long)(16*(wid&3)+(lane>>2))*DM+(wid>>2)*32+(lane&3)*8;
  const unsigned kdst=lds0+LDS_K+wid*1024, vdst=lds0+LDS_V+wid*1024;
  #define DMA_K(t,slot) glds16(ksrc+(long)(t)*KVBLK*DM,(unsigned)__builtin_amdgcn_readfirstlane(kdst+(slot)))
  #define DMA_V(t,slot) glds16(vsrc+(long)(t)*KVBLK*DM,(unsigned)__builtin_amdgcn_readfirstlane(vdst+(slot)))
  const int vb0=(int)(lds0+LDS_V)+((lane>>4)&1)*32+(lane&3)*8+(4*hi+((lane&15)>>2))*64;
  const char*Kbase=shm+LDS_K; bf16x8 kf[8];
  const lds_cptr shm3=(lds_cptr)shm; const lds_cptr kp0=shm3+LDS_K+hi*1024+r32*16; const lds_cptr vp0=shm3+LDS_V+((lane>>4)&1)*32+(lane&3)*8+(4*hi+((lane&15)>>2))*64;
  const int NT=(q0+QB)/KVBLK;
  DMA_K(0,0);DMA_V(0,0);DMA_K(1,SLOTB);
  bf16x8 qr[4];
  #pragma unroll
  for(int d0=0;d0<4;++d0)qr[d0]=*reinterpret_cast<const bf16x8*>(&Qw[(long)r32*DM+d0*16+hi*8]);
  if(build_ck){ const int n=q0+QB; const float*lfp=LF+(size_t)(b*NHEAD+h)*SEQ; const int r0=tid*8;
    typedef float f4_t __attribute__((ext_vector_type(4)));
    float v[8];
    if(r0<n){ const f4_t a=*(const f4_t*)(lfp+(n-8-r0)), c=*(const f4_t*)(lfp+(n-4-r0)); v[0]=c[3];v[1]=c[2];v[2]=c[1];v[3]=c[0];v[4]=a[3];v[5]=a[2];v[6]=a[1];v[7]=a[0]; }
    else { _Pragma("unroll") for(int i=0;i<8;++i)v[i]=0.f; }
    float e[8]; e[0]=0.f; _Pragma("unroll") for(int i=1;i<8;++i)e[i]=e[i-1]+v[i-1];
    const float tot=e[7]+v[7]; float x=tot;
    int lo_=lane; asm volatile("":"+v"(lo_));
    _Pragma("unroll") for(int o=1;o<64;o<<=1){ const float y=__int_as_float(__builtin_amdgcn_ds_bpermute((lo_-o)<<2,__float_as_int(x))); if(lo_>=o)x+=y; }
    __attribute__((address_space(3))) float*ckw=(__attribute__((address_space(3))) float*)((lds_cptr)shm+LDS_CKW);
    __attribute__((address_space(3))) float*ckp=(__attribute__((address_space(3))) float*)((lds_cptr)shm+LDS_CK);
    if(lo_==63)ckw[wid]=x;
    asm volatile("s_waitcnt lgkmcnt(0)\n\ts_barrier":::"memory");
    float base=0.f; _Pragma("unroll") for(int w=0;w<8;++w){ const float tw=ckw[w]; if(w<wid)base+=tw; }
    const float ex=base+(x-tot);
    __attribute__((address_space(3))) u32x2*kap=(__attribute__((address_space(3))) u32x2*)((lds_cptr)shm+LDS_KA);
    if(r0<n){ _Pragma("unroll") for(int i=0;i<8;++i){ const float xv=-1.4426950408889634f*(ex+e[i]); ckp[n-1-r0-i]=xv;
      const unsigned ph=cvtpk_s(xv,0.f)&0xffffu; const float r1=xv-__uint_as_float(ph<<16); const unsigned pm=cvtpk_s(r1,0.f)&0xffffu; const float r2=r1-__uint_as_float(pm<<16); const unsigned pl=cvtpk_s(r2,0.f)&0xffffu;
      kap[n-1-r0-i]=(u32x2){ph|(pm<<16),pl|0x3F800000u}; } }
    asm volatile("s_waitcnt lgkmcnt(0)\n\ts_barrier":::"memory");
  }
  float mhat=0.f,l_reg=0.f;f32x16 o[2];o[0]=f32x16{};o[1]=f32x16{};
  const int qrel=wid*QBLK+r32;
  typedef float f4_t __attribute__((ext_vector_type(4)));
  const __attribute__((address_space(3))) float*ckb=(const __attribute__((address_space(3))) float*)((lds_cptr)shm+LDS_CK);
  const float cq=ckb[q0+qrel];
  const __attribute__((address_space(3))) u32x2*kab=(const __attribute__((address_space(3))) u32x2*)((lds_cptr)shm+LDS_KA)+r32;
  u32x4 qaug; u32x2 kaw0,kaw1; const f32x16 z16=f32x16{};
  #define QAUG() do{ const float a_=cq-mhat; const unsigned ph_=cvtpk_s(a_,0.f)&0xffffu; const float r1_=a_-__uint_as_float(ph_<<16); const unsigned pm_=cvtpk_s(r1_,0.f)&0xffffu; \
    const unsigned pl_=cvtpk_s(r1_-__uint_as_float(pm_<<16),0.f)&0xffffu; qaug=hi?(u32x4){0u,0u,0u,0u}:(u32x4){0xBF80BF80u,0xBF80u|(ph_<<16),pm_|(pl_<<16),0u}; }while(0)
  #define KAL(tt) do{ kaw0=kab[64*(tt)]; kaw1=kab[64*(tt)+32]; }while(0)
  #define KAF(w) __builtin_bit_cast(bf16x8,(u32x4){w[0],w[1],0x3F803F80u,0u})
  #define QAF __builtin_bit_cast(bf16x8,qaug)
  #define AUGM(X0,X1) do{ X0=__builtin_amdgcn_mfma_f32_32x32x16_bf16(KAF(kaw0),QAF,z16,0,0,0); X1=__builtin_amdgcn_mfma_f32_32x32x16_bf16(KAF(kaw1),QAF,z16,0,0,0); }while(0)
  #define CMASK(P0,P1,t) do{int jb_=(t)-(NT-4); if(jb_>=0)cmask(P0,P1,jb_,qrel,hi);}while(0)
  bool resc=false;
  #define START(P0,P1) do{ const float rm=rowmax(P0,P1); resc=false; \
    { const float dl=__builtin_fmaxf(rm,0.f); mhat=fadd_s(mhat,dl);     \
      _Pragma("unroll") for(int r=0;r<16;++r){P0[r]=fsub_s(P0[r],dl);P1[r]=fsub_s(P1[r],dl);} } \
    _Pragma("unroll") for(int r=0;r<16;++r)P0[r]=__builtin_amdgcn_exp2f(P0[r]); }while(0)
  #define RESC() do{ if(resc){ asm volatile("s_waitcnt lgkmcnt(0)":::"memory"); \
      _Pragma("unroll") for(int d_=0;d_<2;++d_) _Pragma("unroll") for(int r=0;r<16;++r)o[d_][r]*=wsf[crow(r,hi)]; } }while(0)
  f32x16 pA0,pA1,pB0,pB1;
  int sl_prev=0,sl_cur=0,sl_next=SLOTB;
  #define ROT() do{sl_prev=sl_cur;sl_cur=sl_next;sl_next=(sl_next==(NSLOT-1)*SLOTB)?0:sl_next+SLOTB;}while(0)
  DMA_K(2,2*SLOTB);
  WAIT_BAR(3);
  QAUG(); KAL(0); AUGM(pA0,pA1);
  qkt(pA0,pA1,Kbase,qr,r32,hi);asm volatile("s_nop 15\n\ts_nop 7":"+v"(pA0),"+v"(pA1));CMASK(pA0,pA1,0);
  START(pA0,pA1);
  QAUG(); KAL(1); AUGM(pB0,pB1);
  _Pragma("unroll") for(int r=0;r<16;++r)pA1[r]=__builtin_amdgcn_exp2f(pA1[r]);
  WAIT_BAR(0);
  DMA_K(3,0);DMA_V(1,SLOTB);
  ROT();
  kload8(kf,kp0+sl_cur);
  WAIT_BAR(2);
  s16x4 vlo[8],vhi[8]; u32x4 pw0,pw1,pw2,pw3;
  #define PKW(P,B) cvtpk_s(P[B],P[B+1])
  #define PAF(k) __builtin_bit_cast(bf16x8,pw##k)
  #define VFR(i) (bf16x8){vlo[i][0],vlo[i][1],vlo[i][2],vlo[i][3],vhi[i][0],vhi[i][1],vhi[i][2],vhi[i][3]}
  #define PIN(x) asm volatile("":"+v"(x))
  #define MX3(a,b,c) __builtin_fmaxf(__builtin_fmaxf((a),(b)),(c))
  #define GAPA(MF,A0,A1,A2,A3,W0,W1,PW) do{ MF; sacc+=A0; sacc+=A1; sacc+=A2; sacc+=A3; PIN(sacc); W0; W1; PIN(PW); SBAR(); }while(0)
  #define EX(v) __builtin_amdgcn_exp2f(v)
  #define GAPB(MF,X,B) do{ MF; X[B]=EX(X[B]); X[B+1]=EX(X[B+1]); X[B+2]=EX(X[B+2]); X[B+3]=EX(X[B+3]); PIN(X); SBAR(); }while(0)
  #define VRD(i) do{ vlo[i]=vtr(vp_+(((i)>>2)*4096+((i)&3)*1024)); vhi[i]=vtr(vp_+(((i)>>2)*4096+((i)&3)*1024+512)); }while(0)
  #define KRD(G,j) do{ if(G){ kload2(kf,kp0+sl_next,j); SBAR(); } }while(0)
  #define STEP(C0,C1,P0,P1,t,GK,GV,GL,GI) do{ SBAR(); \
    const lds_cptr vp_=vp0+sl_prev; \
    if(GI){ KAL((t)+1); } \
    VRD(0); SBAR(); float sacc=(P0[0]+P0[1]); \
    GAPA(C0=__builtin_amdgcn_mfma_f32_32x32x16_bf16(kf[0],qr[0],C0,0,0,0), P0[2],P0[3],P0[4],P0[5],     pw0[0]=PKW(P0,0), pw0[1]=PKW(P0,2), pw0); \
    VRD(4); SBAR(); GAPA(C1=__builtin_amdgcn_mfma_f32_32x32x16_bf16(kf[1],qr[0],C1,0,0,0), P0[6],P0[7],P0[8],P0[9],     pw0[2]=PKW(P0,4), pw0[3]=PKW(P0,6), pw0); \
    VRD(1); SBAR(); GAPA(C0=__builtin_amdgcn_mfma_f32_32x32x16_bf16(kf[2],qr[1],C0,0,0,0),   P0[10],P0[11],P0[12],P0[13], pw1[0]=PKW(P0,8), pw1[1]=PKW(P0,10), pw1); \
    VRD(5); SBAR(); GAPA(C1=__builtin_amdgcn_mfma_f32_32x32x16_bf16(kf[3],qr[1],C1,0,0,0),   P0[14],P0[15],P1[0],P1[1],   pw1[2]=PKW(P0,12),pw1[3]=PKW(P0,14), pw1); \
    VRD(2); SBAR(); GAPA(C0=__builtin_amdgcn_mfma_f32_32x32x16_bf16(kf[4],qr[2],C0,0,0,0),   P1[2],P1[3],P1[4],P1[5],     pw2[0]=PKW(P1,0), pw2[1]=PKW(P1,2), pw2); \
    VRD(6); SBAR(); GAPA(C1=__builtin_amdgcn_mfma_f32_32x32x16_bf16(kf[5],qr[2],C1,0,0,0),   P1[6],P1[7],P1[8],P1[9],     pw2[2]=PKW(P1,4), pw2[3]=PKW(P1,6), pw2); \
    VRD(3); SBAR(); GAPA(C0=__builtin_amdgcn_mfma_f32_32x32x16_bf16(kf[6],qr[3],C0,0,0,0),   P1[10],P1[11],P1[12],P1[13], pw3[0]=PKW(P1,8), pw3[1]=PKW(P1,10), pw3); \
    VRD(7); SBAR(); GAPA(C1=__builtin_amdgcn_mfma_f32_32x32x16_bf16(kf[7],qr[3],C1,0,0,0),   P1[14],P1[15],0.f,0.f,       pw3[2]=PKW(P1,12),pw3[3]=PKW(P1,14), pw3); \
    l_reg+=sacc; \
    if(GK){DMA_K((t)+3,sl_cur);} if(GV){DMA_V((t)+1,sl_next);} \
    CMASK(C0,C1,t); \
    { float a=MX3(C0[0],C0[1],C1[0]),b=MX3(C0[2],C0[3],C1[1]); a=MX3(a,C1[2],C1[3]); \
      _Pragma("unroll") for(int r=4;r<16;r+=4){a=MX3(a,C0[r],C0[r+1]);b=MX3(b,C0[r+2],C0[r+3]);a=MX3(a,C1[r],C1[r+1]);b=MX3(b,C1[r+2],C1[r+3]);} \
      float rm=__builtin_fmaxf(a,b); { auto rr=__builtin_amdgcn_permlane32_swap(__float_as_uint(rm),__float_as_uint(rm),false,false); rm=__builtin_fmaxf(__uint_as_float(rr[0]),__uint_as_float(rr[1])); } \
      resc=false; \
      if(__builtin_expect(__any(rm>(float)THRL),0)){ const float dl=__builtin_fmaxf(rm,0.f); mhat+=dl; QAUG(); \
        _Pragma("unroll") for(int r=0;r<16;++r){C0[r]-=dl;C1[r]-=dl;} \
        const float f=__builtin_amdgcn_exp2f(-dl); l_reg*=f; if(hi==0)wsf[r32]=f; resc=true; } } \
    if(GI){ AUGM(P0,P1); } \
    SBAR(); \
    GAPB(o[0]=__builtin_amdgcn_mfma_f32_32x32x16_bf16(PAF(0),VFR(0),o[0],0,0,0), C0,0); \
    GAPB(o[1]=__builtin_amdgcn_mfma_f32_32x32x16_bf16(PAF(0),VFR(4),o[1],0,0,0), C0,4); \
    KRD(GL,0); GAPB(o[0]=__builtin_amdgcn_mfma_f32_32x32x16_bf16(PAF(1),VFR(1),o[0],0,0,0), C0,8); \
    KRD(GL,1); GAPB(o[1]=__builtin_amdgcn_mfma_f32_32x32x16_bf16(PAF(1),VFR(5),o[1],0,0,0), C0,12); \
    KRD(GL,2); GAPB(o[0]=__builtin_amdgcn_mfma_f32_32x32x16_bf16(PAF(2),VFR(2),o[0],0,0,0), C1,0); \
    KRD(GL,3); GAPB(o[1]=__builtin_amdgcn_mfma_f32_32x32x16_bf16(PAF(2),VFR(6),o[1],0,0,0), C1,4); \
    GAPB(o[0]=__builtin_amdgcn_mfma_f32_32x32x16_bf16(PAF(3),VFR(3),o[0],0,0,0), C1,8); \
    GAPB(o[1]=__builtin_amdgcn_mfma_f32_32x32x16_bf16(PAF(3),VFR(7),o[1],0,0,0), C1,12); \
    }while(0)
  int t=1;
  #undef CMASK
  #define CMASK(P0,P1,t) do{}while(0)
  for(;t+5<NT;t+=2){
    STEP(pB0,pB1,pA0,pA1,t,true,true,true,true);     WAIT_BAR(2); RESC(); ROT();
    STEP(pA0,pA1,pB0,pB1,t+1,true,true,true,true);   WAIT_BAR(2); RESC(); ROT();
  }
  #undef CMASK
  #define CMASK(P0,P1,t) do{int jb_=(t)-(NT-4); if(jb_>=0)cmask(P0,P1,jb_,qrel,hi);}while(0)
  #define ENDW(tt) do{ if((tt)+3<NT){WAIT_BAR(2);} else if((tt)+2<NT){WAIT_BAR(1);} else {WAIT_BAR(0);} }while(0)
  for(;t+1<NT;t+=2){
    STEP(pB0,pB1,pA0,pA1,t,(t+3<NT),(t+1<NT),(t+1<NT),(t+1<NT));       ENDW(t);   RESC(); ROT();
    STEP(pA0,pA1,pB0,pB1,t+1,(t+4<NT),(t+2<NT),(t+2<NT),(t+2<NT));     ENDW(t+1); RESC(); ROT();
  }
  STEP(pB0,pB1,pA0,pA1,NT-1,false,false,false,false); RESC();
  { float sacc=pB0[0]+pB0[1]; _Pragma("unroll") for(int r=2;r<16;++r)sacc+=pB0[r]; _Pragma("unroll") for(int r=0;r<16;++r)sacc+=pB1[r]; l_reg+=sacc;
    pw0=(u32x4){PKW(pB0,0),PKW(pB0,2),PKW(pB0,4),PKW(pB0,6)};pw1=(u32x4){PKW(pB0,8),PKW(pB0,10),PKW(pB0,12),PKW(pB0,14)};pw2=(u32x4){PKW(pB1,0),PKW(pB1,2),PKW(pB1,4),PKW(pB1,6)};pw3=(u32x4){PKW(pB1,8),PKW(pB1,10),PKW(pB1,12),PKW(pB1,14)};
    SBAR(); pv(o,vb0+sl_cur,PAF(0),PAF(1),PAF(2),PAF(3)); }
  #undef PKW
  #undef PAF
  #undef VFR
  #undef PIN
  #undef MX3
  #undef GAPA
  #undef GAPB
  #undef EX
  #undef VRD
  #undef KRD
  #undef STEP
  #undef ENDW
  {auto rr=__builtin_amdgcn_permlane32_swap(__float_as_uint(l_reg),__float_as_uint(l_reg),false,false);l_reg=__uint_as_float(rr[0])+__uint_as_float(rr[1]);}
  if(hi==0)wsf[32+r32]=l_reg;asm volatile("s_waitcnt lgkmcnt(0)":::"memory");
  float rli[16];
  #pragma unroll
  for(int r=0;r<16;++r)rli[r]=__builtin_amdgcn_rcpf(wsf[32+crow(r,hi)]);
  bf16*Ow=O+(rowbase+q0+wid*QBLK)*OPITCH+h*D;
  { bf16*stg=(bf16*)(shm+LDS_OST)+wid*2048;
    #pragma unroll
    for(int r=0;r<16;++r){const int orow=crow(r,hi);
      #pragma unroll
      for(int d0=0;d0<2;++d0)stg[orow*64+d0*32+r32]=__float2bfloat16(o[d0][r]*rli[r]);}
    asm volatile("s_waitcnt lgkmcnt(0)":::"memory");
    #pragma unroll
    for(int i=0;i<4;++i){const int row=i*8+(lane>>3),ch=lane&7; const u32x4 v=*(const u32x4*)(stg+row*64+ch*8); ATTN_STORE16(Ow+(long)row*OPITCH+ch*8,v);} }
  asm volatile("s_waitcnt lgkmcnt(0)\n\ts_barrier":::"memory");
  #undef DMA_K
  #undef DMA_V
  #undef CMASK
  #undef START
  #undef RESC
  #undef ROT
  #undef QAUG
  #undef KAL
  #undef KAF
  #undef QAF
  #undef AUGM
}
constexpr int ATTN_LDS_BYTES=LDS_TOTAL;
struct AttnTensors { const bf16* Q; const bf16* K; const bf16* V; bf16* O; const float* LF; };
struct AttnUnit { int bh; int qb; };
struct StaticOrder {
  int vcu;
  __device__ __forceinline__ explicit StaticOrder(int grid,int block):vcu((block%8)*(grid/8)+block/8){}
  __device__ __forceinline__ bool next(int i,AttnUnit&u)const{ if(i>=2)return false; const int s=vcu&7; u.bh=vcu>>3; u.qb=(i==0)?15-s:s; return true; }
  __device__ __forceinline__ void a_ready(const AttnUnit&)const{}
  __device__ __forceinline__ void done(const AttnUnit&)const{}
};
template<class Sched,int THRL=8> __device__ __forceinline__ void attn_phase(char*lds,const AttnTensors&T,const Sched&S){
  AttnUnit u;
  for(int i=0;S.next(i,u);++i){ S.a_ready(u); attn_unit<THRL>(u.bh/NHEAD,u.bh%NHEAD,u.qb,T.Q,T.K,T.V,T.O,T.LF,lds,i==0); S.done(u); }
}
#undef SBAR
#undef WAIT_BAR
}
__device__ __forceinline__ void p0_transpose_item(const float* W, int K, int ldw, int src_col0, int nvalid, bf16_t* WT, int n0, int k0, LAS float* scr, int lane, const float* kgain) {
    { const GAS float* Wg = (const GAS float*)W; const GAS float* gg_ = (const GAS float*)kgain; const int l = lane & 31, lc = l < nvalid ? l : 0; float v[32];
#pragma unroll
        for (int i = 0; i < 32; ++i) { const int kk = 2 * i + (lane >> 5); v[i] = __builtin_nontemporal_load(Wg + (size_t)(k0 + kk) * ldw + src_col0 + lc); }
        if (kgain) {
#pragma unroll
            for (int i = 0; i < 32; ++i) v[i] *= gg_[k0 + 2 * i + (lane >> 5)]; }
#pragma unroll
        for (int i = 0; i < 32; ++i) scr[(2 * i + (lane >> 5)) * 33 + l] = (l < nvalid) ? v[i] : 0.f; }
    LDS_WAIT(); asm volatile("" ::: "memory");
    const int c = lane & 7;
#pragma unroll
    for (int j = 0; j < 4; ++j) { const int n = (lane >> 3) + 8 * j; const LAS float* s = scr + (8 * c) * 33 + n;
        v4u o; o.x = pk2(s[0 * 33], s[1 * 33]); o.y = pk2(s[2 * 33], s[3 * 33]); o.z = pk2(s[4 * 33], s[5 * 33]); o.w = pk2(s[6 * 33], s[7 * 33]);
        *(GAS v4u*)(WT + (size_t)(n0 + n) * K + k0 + 8 * c) = o; }
    LDS_WAIT(); asm volatile("" ::: "memory");
}
__device__ __forceinline__ void row_to_bf16_inv(const float* xrow, bf16_t* orow, float* invp, int lane) {
    const GAS f32x4* xr = (const GAS f32x4*)xrow + lane;
    f32x4 v[4]; float s = 0.f;
#pragma unroll
    for (int j = 0; j < 4; ++j) { v[j] = __builtin_nontemporal_load(xr + 64 * j); s += (v[j].x * v[j].x + v[j].y * v[j].y) + (v[j].z * v[j].z + v[j].w * v[j].w); }
    const float inv = 1.0f / sqrtf(wave_sum(s) * (1.f / DM) + 1e-6f);
    GAS unsigned long long* o8 = (GAS unsigned long long*)orow + lane;
#pragma unroll
    for (int j = 0; j < 4; ++j) o8[64 * j] = (unsigned long long)pk2(v[j].x, v[j].y) | ((unsigned long long)pk2(v[j].z, v[j].w) << 32);
    if (lane == 0) *invp = inv;
}
namespace lru {
constexpr int ROWB = 144, TILE_B = 67 * ROWB  , CW_OFF = 9728, WAVE_LDS = 11264;
__device__ __forceinline__ float fast_sigmoid(float z) { return __builtin_amdgcn_rcpf(1.0f + __builtin_amdgcn_exp2f(-1.4426950408889634f * z)); }
__device__ __forceinline__ void stage1(int item, int wave, int lane, LAS unsigned char* Lw, const bf16_t* ri, const bf16_t* wlru, const float* cw, const float* cb,
                                       const float* ba, const float* bx, const float* lam, float* sumP, float* sumH, f32x16 (&Pc)[2][2], f32x16 (&Hl)[2][2]) {
    const int b = item >> 6, c = item & 63, t0 = c * 64; const size_t n0 = (size_t)b * SEQ + t0;
    const int r32 = lane & 31, hi = lane >> 5, chb = wave * 64;
    { v4u sv[9];
#pragma unroll
        for (int pass = 0; pass < 9; ++pass) { const int row = pass * 8 + (lane >> 3), rc = row < 67 ? row : 66; const bool ok = (t0 - 3 + rc) >= 0;
            sv[pass] = *(const GAS v4u*)(ri + (n0 + (ok ? rc - 3 : 0)) * 512 + chb + 8 * (lane & 7)); if (!ok) sv[pass] = (v4u){0u, 0u, 0u, 0u}; }
#pragma unroll
        for (int pass = 0; pass < 9; ++pass) { const int row = pass * 8 + (lane >> 3); if (row < 67) *(LAS v4u*)(Lw + row * ROWB + (lane & 7) * 16) = sv[pass]; } }
    LAS float* cwl = (LAS float*)(Lw + CW_OFF);
    { const GAS float* cwg = (const GAS float*)cw; float cv[5];
#pragma unroll
        for (int tap = 0; tap < 4; ++tap) cv[tap] = cwg[tap * 512 + chb + lane];
        cv[4] = ((const GAS float*)cb)[chb + lane];
#pragma unroll
        for (int tap = 0; tap < 4; ++tap) cwl[tap * 64 + lane] = cv[tap];
        cwl[256 + lane] = cv[4]; }
    bf16x8 bfa[8];
#pragma unroll
    for (int f = 0; f < 8; ++f) bfa[f] = *((const GAS bf16x8*)wlru + ((size_t)(wave * 8 + f)) * 64 + lane);
    float cba[2], cbx[2], clam[2];
#pragma unroll
    for (int nt = 0; nt < 2; ++nt) { const int gch = chb + 32 * nt + r32; cba[nt] = ((const GAS float*)ba)[gch]; cbx[nt] = ((const GAS float*)bx)[gch]; clam[nt] = ((const GAS float*)lam)[gch]; }
    asm volatile("s_waitcnt vmcnt(0) lgkmcnt(0)" ::: "memory");
    bf16x8 af[2][4];
#pragma unroll
    for (int ks = 0; ks < 4; ++ks) { const int cof = 16 * ks + 8 * hi;
        f32x4 w[4][2], bb[2];
#pragma unroll
        for (int tap = 0; tap < 4; ++tap) { w[tap][0] = *(const LAS f32x4*)(cwl + tap * 64 + cof); w[tap][1] = *(const LAS f32x4*)(cwl + tap * 64 + cof + 4); }
        bb[0] = *(const LAS f32x4*)(cwl + 256 + cof); bb[1] = *(const LAS f32x4*)(cwl + 256 + cof + 4);
#pragma unroll
        for (int mt = 0; mt < 2; ++mt) { const int tl = 32 * mt + r32;
            float a8[8];
#pragma unroll
            for (int e = 0; e < 8; ++e) a8[e] = bb[e >> 2][e & 3];
#pragma unroll
            for (int tap = 0; tap < 4; ++tap) { const v4u d = *(const LAS v4u*)(Lw + (tl + tap) * ROWB + cof * 2);
#pragma unroll
                for (int e = 0; e < 8; ++e) { const unsigned dw = d[e >> 1]; const float xv = __uint_as_float((e & 1) ? (dw & 0xffff0000u) : (dw << 16)); a8[e] += w[tap][e >> 2][e & 3] * xv; } }
            v4u pk; pk.x = pk2(a8[0], a8[1]); pk.y = pk2(a8[2], a8[3]); pk.z = pk2(a8[4], a8[5]); pk.w = pk2(a8[6], a8[7]);
            af[mt][ks] = __builtin_bit_cast(bf16x8, pk);
            asm volatile("s_waitcnt lgkmcnt(0)" ::: "memory");
            *(LAS v4u*)(Lw + tl * ROWB + cof * 2) = pk; }
    }
    f32x16 acc[2][2][2];
#pragma unroll
    for (int mat = 0; mat < 2; ++mat)
#pragma unroll
        for (int mt = 0; mt < 2; ++mt)
#pragma unroll
            for (int nt = 0; nt < 2; ++nt) acc[mat][mt][nt] = (f32x16){};
#pragma unroll
    for (int mat = 0; mat < 2; ++mat)
#pragma unroll
        for (int nt = 0; nt < 2; ++nt)
#pragma unroll
            for (int ks = 0; ks < 4; ++ks) { const bf16x8 bfr = (mat == 0) ? bfa[nt * 4 + ks] : *((const GAS bf16x8*)wlru + ((size_t)((mat * 8 + wave) * 8 + nt * 4 + ks)) * 64 + lane);
#pragma unroll
                for (int mt = 0; mt < 2; ++mt) acc[mat][mt][nt] = __builtin_amdgcn_mfma_f32_32x32x16_bf16(af[mt][ks], bfr, acc[mat][mt][nt], 0, 0, 0); }
    asm volatile("s_waitcnt lgkmcnt(0)" ::: "memory");
#pragma unroll
    for (int nt = 0; nt < 2; ++nt) { const int ch = 32 * nt + r32, gch = chb + ch;
        const float bav = cba[nt], bxv = cbx[nt]; const float nl = -clam[nt];
        const float k8 = -8.0f * 1.4426950408889634f * (fmaxf(nl, 0.f) + log1pf(expf(-fabsf(nl))));
#pragma unroll
        for (int mt = 0; mt < 2; ++mt)
#pragma unroll
            for (int r = 0; r < 16; ++r) { const int tl = 32 * mt + (r & 3) + 8 * (r >> 2) + 4 * hi;
                const float rec = bf2f(*(const LAS bf16_t*)(Lw + tl * ROWB + ch * 2));
                const float rg = fast_sigmoid(acc[0][mt][nt][r] + bav), ig = fast_sigmoid(acc[1][mt][nt][r] + bxv);
                const float a = __builtin_amdgcn_exp2f(k8 * rg);
                const float mult = __builtin_amdgcn_sqrtf(fmaxf(1.0f - a * a, 0.f));
                acc[0][mt][nt][r] = a; acc[1][mt][nt][r] = mult * ig * rec; }
        float gA[8], gH[8], pA[8], pH[8], myc[8], myp[8];
#pragma unroll
        for (int g = 0; g < 8; ++g) { const int mt = g >> 2, q4 = g & 3; float h = 0.f, p = 1.f;
#pragma unroll
            for (int i = 0; i < 4; ++i) { const float a = acc[0][mt][nt][4 * q4 + i]; h = a * h + acc[1][mt][nt][4 * q4 + i]; p *= a; }
            gA[g] = p; gH[g] = h; }
#pragma unroll
        for (int g = 0; g < 8; ++g) { pA[g] = __shfl_xor(gA[g], 32); pH[g] = __shfl_xor(gH[g], 32); }
        float cin = 0.f, pin = 1.f;
#pragma unroll
        for (int g = 0; g < 8; ++g) {
            const float A0 = hi ? pA[g] : gA[g], H0 = hi ? pH[g] : gH[g], A1 = hi ? gA[g] : pA[g], H1 = hi ? gH[g] : pH[g];
            const float cin1 = A0 * cin + H0, pin1 = A0 * pin;
            myc[g] = hi ? cin1 : cin; myp[g] = hi ? pin1 : pin;
            cin = A1 * cin1 + H1; pin = A1 * pin1; }
        if (hi == 0) { sumP[(size_t)item * 512 + gch] = pin; sumH[(size_t)item * 512 + gch] = cin; }
#pragma unroll
        for (int g = 0; g < 8; ++g) { const int mt = g >> 2, q4 = g & 3; float h = myc[g], p = myp[g];
#pragma unroll
            for (int i = 0; i < 4; ++i) { const int r = 4 * q4 + i; const float a = acc[0][mt][nt][r]; h = a * h + acc[1][mt][nt][r]; p = a * p; Hl[mt][nt][r] = h; Pc[mt][nt][r] = p; } }
    }
}
__device__ __forceinline__ void stage2_loadg(int item, int wave, int lane, const bf16_t* gg, v4u (&gv)[8]) {
    const int b = item >> 6, c = item & 63, t0 = c * 64; const size_t n0 = (size_t)b * SEQ + t0; const int chb = wave * 64;
#pragma unroll
    for (int pass = 0; pass < 8; ++pass) { const int row = pass * 8 + (lane >> 3), cof = 8 * (lane & 7); gv[pass] = *(const GAS v4u*)(gg + (n0 + row) * 512 + chb + cof); }
}
__device__ __forceinline__ void stage2(int item, int wave, int lane, LAS unsigned char* Lw, const v4u (&gvp)[8], bf16_t* ao, const float* sumP, const float* sumH,
                                       const f32x16 (&Pc)[2][2], const f32x16 (&Hl)[2][2]) {
    const int b = item >> 6, c = item & 63, t0 = c * 64; const size_t n0 = (size_t)b * SEQ + t0;
    const int r32 = lane & 31, hi = lane >> 5, chb = wave * 64;
    float carry;
    { typedef float f4l __attribute__((ext_vector_type(4)));
        const int g = lane >> 4, q = lane & 15;
        const GAS f4l* sp4 = (const GAS f4l*)(sumP + (size_t)(b * 64 + 16 * g) * 512 + chb) + q; const GAS f4l* sh4 = (const GAS f4l*)(sumH + (size_t)(b * 64 + 16 * g) * 512 + chb) + q;
        f4l p4 = (f4l){1.f, 1.f, 1.f, 1.f}, h4 = (f4l){0.f, 0.f, 0.f, 0.f};
#pragma unroll
        for (int half = 0; half < 2; ++half) { f4l P[8], H[8];
#pragma unroll
            for (int j = 0; j < 8; ++j) { P[j] = sp4[(size_t)(8 * half + j) * 128]; H[j] = sh4[(size_t)(8 * half + j) * 128]; }
#pragma unroll
            for (int j = 0; j < 8; ++j) { const bool on = (16 * g + 8 * half + j) < c; const f4l hn = P[j] * h4 + H[j], pn = P[j] * p4; h4 = on ? hn : h4; p4 = on ? pn : p4; } }
#pragma unroll
        for (int e = 0; e < 4; ++e) { const float pp = __shfl_xor(p4[e], 16), hp = __shfl_xor(h4[e], 16); if (g & 1) { h4[e] = p4[e] * hp + h4[e]; p4[e] = p4[e] * pp; } }
#pragma unroll
        for (int e = 0; e < 4; ++e) { const float pp = __shfl(p4[e], 16 + q), hp = __shfl(h4[e], 16 + q); if (g >= 2) { h4[e] = p4[e] * hp + h4[e]; p4[e] = p4[e] * pp; } }
        const int src = 48 + (lane >> 2); const float c0 = __shfl(h4[0], src), c1 = __shfl(h4[1], src), c2 = __shfl(h4[2], src), c3 = __shfl(h4[3], src);
        carry = (lane & 3) == 0 ? c0 : (lane & 3) == 1 ? c1 : (lane & 3) == 2 ? c2 : c3; }
#pragma unroll
    for (int nt = 0; nt < 2; ++nt) { const int ch = 32 * nt + r32; const float cv = __shfl(carry, ch);
#pragma unroll
        for (int mt = 0; mt < 2; ++mt)
#pragma unroll
            for (int r = 0; r < 16; ++r) { const int tl = 32 * mt + (r & 3) + 8 * (r >> 2) + 4 * hi;
                *(LAS bf16_t*)(Lw + tl * ROWB + ch * 2) = f2bf(Hl[mt][nt][r] + Pc[mt][nt][r] * cv); } }
    asm volatile("s_waitcnt lgkmcnt(0)" ::: "memory");
#pragma unroll
    for (int pass = 0; pass < 8; ++pass) { const int row = pass * 8 + (lane >> 3), cof = 8 * (lane & 7);
        const v4u hv = *(const LAS v4u*)(Lw + row * ROWB + cof * 2); const v4u gv = gvp[pass];
        v4u o;
#pragma unroll
        for (int e = 0; e < 4; ++e) { const float h0 = __uint_as_float(hv[e] << 16), h1 = __uint_as_float(hv[e] & 0xffff0000u), g0 = __uint_as_float(gv[e] << 16), g1 = __uint_as_float(gv[e] & 0xffff0000u); o[e] = pk2(h0 * g0, h1 * g1); }
        *(GAS v4u*)(ao + (n0 + row) * 1024 + 512 + chb + cof) = o; }
    asm volatile("s_waitcnt lgkmcnt(0)" ::: "memory");
}
__device__ __forceinline__ void convert_item(int it, int lane, const float* wa, const float* wx, bf16_t* wlru) {
    const int mat = it >> 3, blk = it & 7, r32 = lane & 31, hi = lane >> 5; const float* W = (mat ? wx : wa) + (size_t)blk * 4096;
    float v[8][8];
#pragma unroll
    for (int f = 0; f < 8; ++f) { const int nt = f >> 2, ks = f & 3;
#pragma unroll
        for (int j = 0; j < 8; ++j) v[f][j] = ((const GAS float*)W)[(16 * ks + 8 * hi + j) * 64 + 32 * nt + r32]; }
#pragma unroll
    for (int f = 0; f < 8; ++f) { v4u o; o.x = pk2(v[f][0], v[f][1]); o.y = pk2(v[f][2], v[f][3]); o.z = pk2(v[f][4], v[f][5]); o.w = pk2(v[f][6], v[f][7]);
        *((GAS v4u*)wlru + ((size_t)(it * 8 + f)) * 64 + lane) = o; }
}
}
namespace moe {
constexpr int LCAP = 16384;
constexpr int AROW = 272, ABUF = 128 * AROW  , HROW = 528, META_OFF = 2 * ABUF  ;
typedef float f4_t __attribute__((ext_vector_type(4)));
__device__ __forceinline__ int crow(int r, int hi) { return (r & 3) + 8 * (r >> 2) + 4 * hi; }
__device__ __forceinline__ unsigned ld_u32_agent(const unsigned* p) { return __hip_atomic_load(p, __ATOMIC_RELAXED, __HIP_MEMORY_SCOPE_AGENT); }

typedef float f2_t __attribute__((ext_vector_type(2))); typedef __bf16 bf2_t __attribute__((ext_vector_type(2))); typedef unsigned long long u64;
constexpr float W1_SCALE = 64.0f, W2_SCALE = 32.0f;
__device__ __forceinline__ u64 pack_fp8x8(const float (&v)[8], float sc) {
    int lo = __builtin_amdgcn_cvt_pk_fp8_f32(v[0] * sc, v[1] * sc, 0, false); lo = __builtin_amdgcn_cvt_pk_fp8_f32(v[2] * sc, v[3] * sc, lo, true);
    int hi = __builtin_amdgcn_cvt_pk_fp8_f32(v[4] * sc, v[5] * sc, 0, false); hi = __builtin_amdgcn_cvt_pk_fp8_f32(v[6] * sc, v[7] * sc, hi, true);
    return (u64)(unsigned)lo | ((u64)(unsigned)hi << 32);
}
__device__ __forceinline__ bf16x8 fp8x8_to_bf16(unsigned lo_, unsigned hi_) {
    const int lo = (int)lo_, hi = (int)hi_;
    const f2_t a = __builtin_amdgcn_cvt_pk_f32_fp8(lo, false), b = __builtin_amdgcn_cvt_pk_f32_fp8(lo, true), c = __builtin_amdgcn_cvt_pk_f32_fp8(hi, false), d = __builtin_amdgcn_cvt_pk_f32_fp8(hi, true);
    v4u o; o.x = __builtin_bit_cast(unsigned, __builtin_convertvector(a, bf2_t)); o.y = __builtin_bit_cast(unsigned, __builtin_convertvector(b, bf2_t));
    o.z = __builtin_bit_cast(unsigned, __builtin_convertvector(c, bf2_t)); o.w = __builtin_bit_cast(unsigned, __builtin_convertvector(d, bf2_t));
    return __builtin_bit_cast(bf16x8, o);
}
__device__ __forceinline__ void pair8_from_kn(const float* W, int ldw, int ksp, int n0, GAS v4u* dst, int lane, const float* kgain, float sc) {
    const int r32 = lane & 31, hi = lane >> 5; float v[2][8];
#pragma unroll
    for (int h = 0; h < 2; ++h)
#pragma unroll
        for (int j = 0; j < 8; ++j) v[h][j] = W[(size_t)(32 * ksp + 16 * h + 8 * hi + j) * ldw + n0 + r32];
    if (kgain) {
#pragma unroll
        for (int h = 0; h < 2; ++h)
#pragma unroll
            for (int j = 0; j < 8; ++j) v[h][j] *= kgain[32 * ksp + 16 * h + 8 * hi + j]; }
    const u64 a = pack_fp8x8(v[0], sc), b = pack_fp8x8(v[1], sc);
    v4u o; o.x = (unsigned)a; o.y = (unsigned)(a >> 32); o.z = (unsigned)b; o.w = (unsigned)(b >> 32);
    dst[lane] = o;
}
__device__ __forceinline__ void frag_from_kn(const float* W, int ldw, int k0, int n0, GAS v4u* dst, int lane, const float* kgain) {
    const int r32 = lane & 31, hi = lane >> 5; float v[8];
#pragma unroll
    for (int j = 0; j < 8; ++j) v[j] = W[(size_t)(k0 + 8 * hi + j) * ldw + n0 + r32];
    if (kgain) {
#pragma unroll
        for (int j = 0; j < 8; ++j) v[j] *= kgain[k0 + 8 * hi + j]; }
    v4u o; o.x = pk2(v[0], v[1]); o.y = pk2(v[2], v[3]); o.z = pk2(v[4], v[5]); o.w = pk2(v[6], v[7]);
    dst[lane] = o;
}
constexpr int CONV_ITEMS = 4096 + 2048 + 128;
struct ConvP { const float* W; int ldw, ksp, n0; const float* gain; float sc; GAS v4u* dst; int dstride; };
__device__ __forceinline__ ConvP conv_decode(int it, const float* wgate, const float* wup, const float* wdown, const float* g2, bf16_t* w1f, bf16_t* w2f) {
    ConvP p;
    if (it < 4096) { const int e = it >> 7, gu = (it >> 6) & 1, fh = (it >> 5) & 1; p.ksp = it & 31; p.W = (gu ? wup : wgate) + (size_t)e * 1024 * 256; p.ldw = 256; p.n0 = 128 * fh; p.gain = g2; p.sc = W1_SCALE;
        p.dst = (GAS v4u*)w1f + ((size_t)((e * 16 + gu * 8 + 4 * fh) * 32 + p.ksp)) * 64; p.dstride = 32 * 64; }
    else { const int r = it - 4096, e = r >> 6, dq = r & 7; p.ksp = (r >> 3) & 7; p.W = wdown + (size_t)e * 256 * 1024; p.ldw = 1024; p.n0 = 128 * dq; p.gain = nullptr; p.sc = W2_SCALE;
        p.dst = (GAS v4u*)w2f + ((size_t)((e * 32 + 4 * dq) * 8 + p.ksp)) * 64; p.dstride = 8 * 64; }
    return p;
}
__device__ __forceinline__ void conv_load(const ConvP& p, int lane, f4_t (&v)[16]) {
    const int r32 = lane & 31, hi = lane >> 5;
#pragma unroll
    for (int i = 0; i < 16; ++i) v[i] = __builtin_nontemporal_load((const GAS f4_t*)(p.W + (size_t)(32 * p.ksp + 2 * i + hi) * p.ldw + p.n0 + 4 * r32));
}
__device__ __forceinline__ void conv_finish(const ConvP& p, int lane, LAS unsigned* T, const f4_t (&v)[16]) {
    const int r32 = lane & 31, hi = lane >> 5;
    float gkv[16];
    { const GAS float* gp = (const GAS float*)(p.gain ? p.gain : p.W);
#pragma unroll
        for (int i = 0; i < 16; ++i) gkv[i] = gp[32 * p.ksp + 2 * i + hi];
        const bool hg_ = p.gain != nullptr;
#pragma unroll
        for (int i = 0; i < 16; ++i) gkv[i] = hg_ ? gkv[i] * p.sc : p.sc; }
#pragma unroll
    for (int i = 0; i < 16; ++i) { const float gk = gkv[i];
        int d = __builtin_amdgcn_cvt_pk_fp8_f32(v[i][0] * gk, v[i][1] * gk, 0, false); d = __builtin_amdgcn_cvt_pk_fp8_f32(v[i][2] * gk, v[i][3] * gk, d, true);
        T[(2 * i + hi) * 33 + r32] = (unsigned)d; }
    asm volatile("s_waitcnt lgkmcnt(0)" ::: "memory");
    const LAS unsigned char* Tb = (const LAS unsigned char*)T;
#pragma unroll
    for (int f = 0; f < 4; ++f) { unsigned w[4];
#pragma unroll
        for (int q = 0; q < 4; ++q) { const int rowb = 16 * (q >> 1) + 8 * hi + 4 * (q & 1); unsigned x = 0;
#pragma unroll
            for (int b = 0; b < 4; ++b) x |= (unsigned)Tb[(rowb + b) * 132 + 32 * f + r32] << (8 * b);
            w[q] = x; }
        p.dst[(size_t)f * p.dstride + lane] = (v4u){w[0], w[1], w[2], w[3]}; }
    asm volatile("s_waitcnt lgkmcnt(0)" ::: "memory");
}
__device__ __forceinline__ void convert_item(int it, int lane, LAS unsigned* T, const float* wgate, const float* wup, const float* wdown, const float* wgrp, const float* winner, const float* g2, bf16_t* w1f, bf16_t* w2f, bf16_t* wrf) {
    if (it < 6144) { const ConvP p = conv_decode(it, wgate, wup, wdown, g2, w1f, w2f); f4_t v[16]; conv_load(p, lane, v); conv_finish(p, lane, T, v);
    } else { const int r = it - 6144, nt = r >> 6, ks = r & 63, r32 = lane & 31, hi = lane >> 5, col = 32 * nt + r32; float v[8];
        { const bool isg = col < 4, isi = col >= 4 && col < 36; const int g = isi ? (col - 4) >> 3 : 0, ee = isi ? (col - 4) & 7 : 0;
            const GAS float* src = isg ? (const GAS float*)wgrp + col : (const GAS float*)winner + (size_t)g * 1024 * 8 + ee; const int str = isg ? 4 : 8;
            float xv[8], gv[8];
#pragma unroll
            for (int j = 0; j < 8; ++j) { const int k = 16 * ks + 8 * hi + j; xv[j] = src[(size_t)k * str]; gv[j] = ((const GAS float*)g2)[k]; }
#pragma unroll
            for (int j = 0; j < 8; ++j) v[j] = (isg || isi) ? xv[j] * gv[j] : 0.f; }
        v4u o; o.x = pk2(v[0], v[1]); o.y = pk2(v[2], v[3]); o.z = pk2(v[4], v[5]); o.w = pk2(v[6], v[7]);
        ((GAS v4u*)wrf)[(size_t)r * 64 + lane] = o; }
}

__device__ __forceinline__ void route_block(int blk, int tid, int wave, int lane, LAS unsigned char* L, const bf16_t* xg, const bf16_t* wrf, const float* ssqp, const float* bg, const float* bi,
                                            unsigned* cnt, unsigned* lists, float* linv, float* lw) {
    const int r32 = lane & 31, hi = lane >> 5, tok0 = blk * 64;
    f32x16 acc[2][2];
#pragma unroll
    for (int mt = 0; mt < 2; ++mt)
#pragma unroll
        for (int nt = 0; nt < 2; ++nt) acc[mt][nt] = (f32x16){};
    { LAS unsigned char* xs = L + wave * (64 * 272);
        v4u xv[16];
#pragma unroll
        for (int i = 0; i < 16; ++i) xv[i] = *(const GAS v4u*)(xg + (size_t)(tok0 + 4 * i + (lane >> 4)) * 1024 + 128 * wave + 8 * (lane & 15));
        bf16x8 bq[8][2];
#pragma unroll
        for (int ksl = 0; ksl < 8; ++ksl)
#pragma unroll
            for (int nt = 0; nt < 2; ++nt) bq[ksl][nt] = *((const GAS bf16x8*)wrf + (size_t)(nt * 64 + 8 * wave + ksl) * 64 + lane);
#pragma unroll
        for (int i = 0; i < 16; ++i) *(LAS v4u*)(xs + (4 * i + (lane >> 4)) * 272 + 16 * (lane & 15)) = xv[i];
        asm volatile("s_waitcnt lgkmcnt(0)" ::: "memory");
#pragma unroll
        for (int ksl = 0; ksl < 8; ++ksl) { bf16x8 a[2];
#pragma unroll
            for (int mt = 0; mt < 2; ++mt) a[mt] = *(const LAS bf16x8*)(xs + (32 * mt + r32) * 272 + 32 * ksl + 16 * hi);
#pragma unroll
            for (int mt = 0; mt < 2; ++mt)
#pragma unroll
                for (int nt = 0; nt < 2; ++nt) acc[mt][nt] = __builtin_amdgcn_mfma_f32_32x32x16_bf16(a[mt], bq[ksl][nt], acc[mt][nt], 0, 0, 0); } }
    __syncthreads();
    LAS float* slab = (LAS float*)L + wave * 64 * 40;
#pragma unroll
    for (int mt = 0; mt < 2; ++mt)
#pragma unroll
        for (int r = 0; r < 16; ++r) { const int tk = 32 * mt + crow(r, hi); slab[tk * 40 + r32] = acc[mt][0][r]; if (r32 < 4) slab[tk * 40 + 32 + r32] = acc[mt][1][r]; }
    LAS unsigned* lc = (LAS unsigned*)(L + 8 * 64 * 40 * 4);
    if (tid < 64) lc[tid] = 0u;
    __syncthreads();
    if (wave == 0) {
        const int tok = tok0 + lane; float lg[36];
#pragma unroll
        for (int j4 = 0; j4 < 9; ++j4) { f4_t s = (f4_t){0.f, 0.f, 0.f, 0.f};
#pragma unroll
            for (int w = 0; w < 8; ++w) s += *(const LAS f4_t*)((const LAS float*)L + (w * 64 + lane) * 40 + 4 * j4);
            lg[4 * j4] = s[0]; lg[4 * j4 + 1] = s[1]; lg[4 * j4 + 2] = s[2]; lg[4 * j4 + 3] = s[3]; }
        float ss = 0.f;
#pragma unroll
        for (int j = 0; j < 4; ++j) { const f4_t v = *(const GAS f4_t*)(ssqp + (size_t)tok * 16 + 4 * j); ss += (v[0] + v[1]) + (v[2] + v[3]); }
        const float inv = 1.0f / sqrtf(ss * (1.0f / 1024.0f) + 1e-6f);
        float gl[4];
#pragma unroll
        for (int g = 0; g < 4; ++g) gl[g] = lg[g] * inv + bg[g];
        int gi = 0; float gm = gl[0];
#pragma unroll
        for (int g = 1; g < 4; ++g) if (gl[g] > gm) { gm = gl[g]; gi = g; }
        float gs = 0.f;
#pragma unroll
        for (int g = 0; g < 4; ++g) gs += expf(gl[g] - gm);
        const float gw = 1.0f / gs;
        float il[8];
#pragma unroll
        for (int e = 0; e < 8; ++e) { float v = lg[4 + e]; float bb = bi[e];
#pragma unroll
            for (int g = 1; g < 4; ++g) { v = (gi == g) ? lg[4 + 8 * g + e] : v; bb = (gi == g) ? bi[8 * g + e] : bb; }
            il[e] = v * inv + bb; }
        int e1 = 0; float m1 = il[0];
#pragma unroll
        for (int e = 1; e < 8; ++e) if (il[e] > m1) { m1 = il[e]; e1 = e; }
        int e2 = 0; float m2 = -3.0e38f;
#pragma unroll
        for (int e = 0; e < 8; ++e) if (e != e1 && il[e] > m2) { m2 = il[e]; e2 = e; }
        const float p2 = expf(m2 - m1), w1 = 1.0f / (1.0f + p2), w2 = p2 / (1.0f + p2);
        const int ge1 = gi * 8 + e1, ge2 = gi * 8 + e2;
        const unsigned rk1 = __hip_atomic_fetch_add(&lc[ge1], 1u, __ATOMIC_RELAXED, __HIP_MEMORY_SCOPE_WORKGROUP);
        const unsigned rk2 = __hip_atomic_fetch_add(&lc[ge2], 1u, __ATOMIC_RELAXED, __HIP_MEMORY_SCOPE_WORKGROUP);
        asm volatile("s_waitcnt lgkmcnt(0)" ::: "memory");
        if (lane < 32) { const unsigned c = lc[lane]; unsigned base = 0u; if (c) base = __hip_atomic_fetch_add(cnt + lane, c, __ATOMIC_RELAXED, __HIP_MEMORY_SCOPE_AGENT); lc[32 + lane] = base; }
        asm volatile("s_waitcnt vmcnt(0) lgkmcnt(0)" ::: "memory");
        const unsigned p1 = lc[32 + ge1] + rk1, p2i = lc[32 + ge2] + rk2;
        lists[(size_t)ge1 * LCAP + p1] = (unsigned)tok * 2u; lists[(size_t)ge2 * LCAP + p2i] = (unsigned)tok * 2u + 1u;
        linv[(size_t)ge1 * LCAP + p1] = inv; linv[(size_t)ge2 * LCAP + p2i] = inv; lw[(size_t)ge1 * LCAP + p1] = gw * w1; lw[(size_t)ge2 * LCAP + p2i] = gw * w2;
    }
}

constexpr int YST_OFF = 71680, YROW = 144, YWAVE = 32 * YROW;
constexpr float Y_SCALE = 16.0f;
template <int NTC> __device__ __forceinline__ void moe_item(int e, int row_off, int R, int tid, int wave, int lane, LAS unsigned char* L, const bf16_t* xg, const bf16_t* w1f, const bf16_t* w2f,
                                         const unsigned* lists, const float* tokinv, const float* slotw, bf16_t* y) {
    lane = fresh_lane(); tid = wave * 64 + lane;
    const int r32 = lane & 31, hi = lane >> 5;
    constexpr int ntc = NTC;
    LAS unsigned* metaS = (LAS unsigned*)(L + META_OFF); LAS float* metaI = (LAS float*)(L + META_OFF + 512); LAS float* metaW = (LAS float*)(L + META_OFF + 1024);
    if (tid < 128) { const size_t li = (size_t)e * LCAP + row_off + (tid < R ? tid : 0); const unsigned ms = lists[li]; const float mi = tokinv[li], mw = slotw[li];
        metaS[tid] = ms; metaI[tid] = mi; metaW[tid] = mw; }
    __syncthreads();
    constexpr int CF = NTC == 1 ? 4 : NTC == 2 ? 2 : 1, RG = 4 / CF, AR = 128 * CF + 16, NCH = 8 / CF, NST = 2 * CF, FBUF = 18432;
    typedef int v8i_t __attribute__((ext_vector_type(8)));
    const int srow = tid >> 4, c16 = tid & 15;
    const int spos = 64 * (c16 >> 3) + 32 * (c16 & 1) + 8 * ((c16 & 7) >> 1);
    v4u st[4];
#pragma unroll
    for (int p = 0; p < 4; ++p) st[p] = *(const GAS v4u*)(xg + (size_t)(metaS[srow + 32 * (p % RG)] >> 1) * 1024 + c16 * 8 + (p / RG) * 128);
    const GAS v4u* wgp = (const GAS v4u*)w1f + ((size_t)(e * 16 + wave) * 32) * 64 + lane;
    const GAS v4u* wup = (const GAS v4u*)w1f + ((size_t)(e * 16 + 8 + wave) * 32) * 64 + lane;
    v4u wgq[4], wuq[4];
#pragma unroll
    for (int s = 0; s < 4; ++s) { wgq[s] = wgp[s * 64]; wuq[s] = wup[s * 64]; }
#define MOE_ST8(buf) do { _Pragma("unroll") for (int p = 0; p < 4; ++p) { \
        int lo_ = __builtin_amdgcn_cvt_pk_fp8_f32(__uint_as_float(st[p].x << 16), __uint_as_float(st[p].x & 0xffff0000u), 0, false); lo_ = __builtin_amdgcn_cvt_pk_fp8_f32(__uint_as_float(st[p].y << 16), __uint_as_float(st[p].y & 0xffff0000u), lo_, true); \
        int hi_ = __builtin_amdgcn_cvt_pk_fp8_f32(__uint_as_float(st[p].z << 16), __uint_as_float(st[p].z & 0xffff0000u), 0, false); hi_ = __builtin_amdgcn_cvt_pk_fp8_f32(__uint_as_float(st[p].w << 16), __uint_as_float(st[p].w & 0xffff0000u), hi_, true); \
        *(LAS unsigned long long*)(L + (buf) * FBUF + (srow + 32 * (p % RG)) * AR + (p / RG) * 128 + spos) = (unsigned long long)(unsigned)lo_ | ((unsigned long long)(unsigned)hi_ << 32); } } while (0)
    MOE_ST8(0);
    f32x16 g[4], u[4];
#pragma unroll
    for (int nt = 0; nt < 4; ++nt) { g[nt] = (f32x16){}; u[nt] = (f32x16){}; }
    __syncthreads();
    for (int kc = 0; kc < NCH; ++kc) {
        if (kc < NCH - 1) {
#pragma unroll
            for (int p = 0; p < 4; ++p) st[p] = *(const GAS v4u*)(xg + (size_t)(metaS[srow + 32 * (p % RG)] >> 1) * 1024 + c16 * 8 + ((kc + 1) * CF + p / RG) * 128); }
        const LAS unsigned char* ab = L + (kc & 1) * FBUF + r32 * AR + hi * 32;
#pragma unroll
        for (int sl = 0; sl < NST; ++sl) { const int S = kc * NST + sl;
            const v4u ga = wgq[2 * (sl & 1)], gb = wgq[2 * (sl & 1) + 1], ua = wuq[2 * (sl & 1)], ub = wuq[2 * (sl & 1) + 1];
            const v8i_t wg8 = (v8i_t){(int)ga.x, (int)ga.y, (int)ga.z, (int)ga.w, (int)gb.x, (int)gb.y, (int)gb.z, (int)gb.w};
            const v8i_t wu8 = (v8i_t){(int)ua.x, (int)ua.y, (int)ua.z, (int)ua.w, (int)ub.x, (int)ub.y, (int)ub.z, (int)ub.w};
            v8i_t tb8[4];
#pragma unroll
            for (int nt = 0; nt < NTC; ++nt) { const v4u t0 = *(const LAS v4u*)(ab + nt * 32 * AR + sl * 64), t1 = *(const LAS v4u*)(ab + nt * 32 * AR + sl * 64 + 16);
                tb8[nt] = (v8i_t){(int)t0.x, (int)t0.y, (int)t0.z, (int)t0.w, (int)t1.x, (int)t1.y, (int)t1.z, (int)t1.w}; }
            if (2 * S + 4 < 32) { wgq[2 * (sl & 1)] = wgp[(size_t)(2 * S + 4) * 64]; wgq[2 * (sl & 1) + 1] = wgp[(size_t)(2 * S + 5) * 64]; wuq[2 * (sl & 1)] = wup[(size_t)(2 * S + 4) * 64]; wuq[2 * (sl & 1) + 1] = wup[(size_t)(2 * S + 5) * 64]; }
#pragma unroll
            for (int nt = 0; nt < NTC; ++nt) {
                g[nt] = __builtin_amdgcn_mfma_scale_f32_32x32x64_f8f6f4(wg8, tb8[nt], g[nt], 0, 0, 0, 0x7f7f7f7f, 0, 0x7f7f7f7f);
                u[nt] = __builtin_amdgcn_mfma_scale_f32_32x32x64_f8f6f4(wu8, tb8[nt], u[nt], 0, 0, 0, 0x7f7f7f7f, 0, 0x7f7f7f7f); } }
        if (kc < NCH - 1) MOE_ST8((kc + 1) & 1);
        __syncthreads();
    }
#undef MOE_ST8
    constexpr float HG_SCALE = 8.0f; constexpr int H8ROW = 272;
#pragma unroll
    for (int nt = 0; nt < NTC; ++nt) { const int tk = 32 * nt + r32; const float inv = metaI[tk] * (1.0f / W1_SCALE);
#pragma unroll
        for (int q = 0; q < 4; ++q) { float h[4];
#pragma unroll
            for (int i = 0; i < 4; ++i) { const float gz = g[nt][4 * q + i] * inv, uz = u[nt][4 * q + i] * inv;
                h[i] = gz * __builtin_amdgcn_rcpf(1.0f + __builtin_amdgcn_exp2f(-1.4426950408889634f * gz)) * uz * HG_SCALE; }
            int d = __builtin_amdgcn_cvt_pk_fp8_f32(h[0], h[1], 0, false); d = __builtin_amdgcn_cvt_pk_fp8_f32(h[2], h[3], d, true);
            *(LAS unsigned*)(L + tk * H8ROW + 64 * (wave >> 1) + 32 * (q & 1) + 8 * (2 * (wave & 1) + (q >> 1)) + 4 * hi) = (unsigned)d; } }
    asm volatile("" ::: "memory");
    const int lane2 = fresh_lane();
    const GAS v4u* r0 = (const GAS v4u*)w2f + ((size_t)(e * 32 + 2 * wave) * 8) * 64 + lane2;
    const GAS v4u* r1 = r0 + 8 * 64;
    v4u q0[4], q1[4];
#pragma unroll
    for (int s = 0; s < 4; ++s) { q0[s] = *r0; q1[s] = *r1; r0 += 64; r1 += 64; }
    __syncthreads();
    LAS unsigned char* yst = L + YST_OFF + wave * YWAVE;
#pragma unroll 1
    for (int pass = 0; pass < 2; ++pass) { const int dtb = 16 * pass + 2 * wave;
        asm volatile("" ::: "memory");
        f32x16 ya[2][4];
#pragma unroll
        for (int d2 = 0; d2 < 2; ++d2)
#pragma unroll
            for (int nt = 0; nt < 4; ++nt) ya[d2][nt] = (f32x16){};
        const LAS unsigned char* hb = L + r32 * H8ROW + hi * 32;
#pragma unroll
        for (int S = 0; S < 4; ++S) {
            const v4u p0a = q0[(2 * S) & 3], p0b = q0[(2 * S + 1) & 3], p1a = q1[(2 * S) & 3], p1b = q1[(2 * S + 1) & 3];
            const v8i_t a08 = (v8i_t){(int)p0a.x, (int)p0a.y, (int)p0a.z, (int)p0a.w, (int)p0b.x, (int)p0b.y, (int)p0b.z, (int)p0b.w};
            const v8i_t a18 = (v8i_t){(int)p1a.x, (int)p1a.y, (int)p1a.z, (int)p1a.w, (int)p1b.x, (int)p1b.y, (int)p1b.z, (int)p1b.w};
            if (S == 2 && pass == 0) { r0 += 120 * 64; r1 += 120 * 64; }
            if (S < 2 || pass == 0) { q0[(2 * S) & 3] = *r0; q1[(2 * S) & 3] = *r1; r0 += 64; r1 += 64; q0[(2 * S + 1) & 3] = *r0; q1[(2 * S + 1) & 3] = *r1; r0 += 64; r1 += 64; }
#pragma unroll
            for (int nt = 0; nt < NTC; ++nt) { const v4u t0 = *(const LAS v4u*)(hb + nt * 32 * H8ROW + S * 64), t1 = *(const LAS v4u*)(hb + nt * 32 * H8ROW + S * 64 + 16);
                const v8i_t tb8 = (v8i_t){(int)t0.x, (int)t0.y, (int)t0.z, (int)t0.w, (int)t1.x, (int)t1.y, (int)t1.z, (int)t1.w};
                ya[0][nt] = __builtin_amdgcn_mfma_scale_f32_32x32x64_f8f6f4(a08, tb8, ya[0][nt], 0, 0, 0, 0x7f7f7f7f, 0, 0x7f7f7f7f);
                ya[1][nt] = __builtin_amdgcn_mfma_scale_f32_32x32x64_f8f6f4(a18, tb8, ya[1][nt], 0, 0, 0, 0x7f7f7f7f, 0, 0x7f7f7f7f); } }
        const int lane3 = fresh_lane();
#pragma unroll
        for (int nt = 0; nt < NTC; ++nt) { const float ysc = metaW[32 * nt + r32] * (Y_SCALE / (HG_SCALE * W2_SCALE));
#pragma unroll
            for (int d2 = 0; d2 < 2; ++d2)
#pragma unroll
                for (int q = 0; q < 4; ++q) { int d = __builtin_amdgcn_cvt_pk_fp8_f32(ya[d2][nt][4 * q] * ysc, ya[d2][nt][4 * q + 1] * ysc, 0, false);
                    d = __builtin_amdgcn_cvt_pk_fp8_f32(ya[d2][nt][4 * q + 2] * ysc, ya[d2][nt][4 * q + 3] * ysc, d, true);
                    *(LAS unsigned*)(yst + r32 * 80 + 32 * d2 + 8 * q + 4 * hi) = (unsigned)d; }
            asm volatile("s_waitcnt lgkmcnt(0)" ::: "memory");
#pragma unroll
            for (int p = 0; p < 2; ++p) { const int row = p * 16 + (lane3 >> 2), ch = lane3 & 3, tk = 32 * nt + row; const v4u v = *(const LAS v4u*)(yst + row * 80 + ch * 16);
                if (tk < R) *(GAS v4u*)((unsigned char*)y + (size_t)metaS[tk] * 1024 + 32 * dtb + ch * 16) = v; }
            asm volatile("s_waitcnt lgkmcnt(0)" ::: "memory"); }
    }
    __syncthreads();
}
__device__ __forceinline__ void moe_phase(int vcu, int G, int tid, int wave, int lane, LAS unsigned char* L, const bf16_t* xg, const bf16_t* w1f, const bf16_t* w2f,
                                          const unsigned* cnt, const unsigned* lists, const float* tokinv, const float* slotw, bf16_t* y) {
    LAS int* sc = (LAS int*)(L + YST_OFF + 8 * YWAVE);
    if (tid < 32) sc[tid] = (int)ld_u32_agent(cnt + tid);
    __syncthreads();
    if (tid < 32) { const int c = sc[tid], r = c & 127; int pf = 0, rk = 0, F = 0, NR = 0;
        for (int k = 0; k < 32; ++k) { const int ck = sc[k], rk_ = ck & 127; if (k < tid) pf += ck >> 7; F += ck >> 7; NR += rk_ > 0; if (rk_ > r || (rk_ == r && k < tid)) rk += 1; }
        sc[32 + tid] = pf; sc[64 + tid] = r > 0 ? rk : 9999; if (tid == 0) { sc[96] = F; sc[97] = NR; } }
    __syncthreads();
    const int F = sc[96], M = F + sc[97];
    for (int r = 0;; ++r) {
        const int i = r * G + ((r & 1) ? (G - 1 - vcu) : vcu);
        if (i >= M) break;
        int e = 0, row_off = 0, R = 128;
        if (i < F) { for (int k = 1; k < 32; ++k) if (sc[32 + k] <= i) e = k; row_off = (i - sc[32 + e]) * 128; }
        else { const int rk = i - F; for (int k = 0; k < 32; ++k) if (sc[64 + k] == rk) e = k; row_off = (sc[e] >> 7) * 128; R = sc[e] & 127; }
        e = __builtin_amdgcn_readfirstlane(e); row_off = __builtin_amdgcn_readfirstlane(row_off); R = __builtin_amdgcn_readfirstlane(R);
        if (R > 96) moe_item<4>(e, row_off, R, tid, wave, lane, L, xg, w1f, w2f, lists, tokinv, slotw, y);
        else if (R > 64) moe_item<3>(e, row_off, R, tid, wave, lane, L, xg, w1f, w2f, lists, tokinv, slotw, y);
        else if (R > 32) moe_item<2>(e, row_off, R, tid, wave, lane, L, xg, w1f, w2f, lists, tokinv, slotw, y);
        else moe_item<1>(e, row_off, R, tid, wave, lane, L, xg, w1f, w2f, lists, tokinv, slotw, y);
    }
}
__device__ __forceinline__ void unpack4(unsigned long long a, float (&f)[4]) {
    f[0] = __uint_as_float((unsigned)a << 16); f[1] = __uint_as_float((unsigned)a & 0xffff0000u); f[2] = __uint_as_float((unsigned)(a >> 32) << 16); f[3] = __uint_as_float((unsigned)(a >> 32) & 0xffff0000u); }
template <int NR> __device__ __forceinline__ void final_rows_loadx(int m, int lane, const bf16_t* x1, unsigned long long (&xa)[NR][4]) {
    typedef unsigned long long u64;
#pragma unroll
    for (int r = 0; r < NR; ++r) { const GAS u64* xr = (const GAS u64*)(x1 + (size_t)(m + r) * 1024) + lane;
#pragma unroll
        for (int j = 0; j < 4; ++j) xa[r][j] = __builtin_nontemporal_load(xr + 64 * j); }
}
template <int NR> __device__ __forceinline__ void final_rows_rest(int m, int lane, const unsigned long long (&xa)[NR][4], const bf16_t* y, const float* fn, float* out) {
    unsigned ya[NR][4], yb[NR][4];
#pragma unroll
    for (int r = 0; r < NR; ++r) { const GAS unsigned* y0 = (const GAS unsigned*)((const unsigned char*)y + (size_t)(2 * (m + r)) * 1024) + lane;
#pragma unroll
        for (int j = 0; j < 4; ++j) { ya[r][j] = __builtin_nontemporal_load(y0 + 64 * j); yb[r][j] = __builtin_nontemporal_load(y0 + 256 + 64 * j); } }
    const GAS f4_t* gr = (const GAS f4_t*)fn + lane; f4_t gg[4];
#pragma unroll
    for (int j = 0; j < 4; ++j) gg[j] = gr[64 * j];
#pragma unroll
    for (int r = 0; r < NR; ++r) { f4_t v[4]; float s = 0.f;
#pragma unroll
        for (int j = 0; j < 4; ++j) { float a[4]; unpack4(xa[r][j], a);
            const f2_t b0 = __builtin_amdgcn_cvt_pk_f32_fp8((int)ya[r][j], false), b1 = __builtin_amdgcn_cvt_pk_f32_fp8((int)ya[r][j], true), c0 = __builtin_amdgcn_cvt_pk_f32_fp8((int)yb[r][j], false), c1 = __builtin_amdgcn_cvt_pk_f32_fp8((int)yb[r][j], true);
            v[j][0] = a[0] + (b0[0] + c0[0]) * (1.0f / Y_SCALE); v[j][1] = a[1] + (b0[1] + c0[1]) * (1.0f / Y_SCALE); v[j][2] = a[2] + (b1[0] + c1[0]) * (1.0f / Y_SCALE); v[j][3] = a[3] + (b1[1] + c1[1]) * (1.0f / Y_SCALE);
#pragma unroll
            for (int i = 0; i < 4; ++i) s += v[j][i] * v[j][i]; }
        const float inv = 1.0f / sqrtf(wave_sum(s) * (1.0f / 1024.0f) + 1e-6f);
        GAS f4_t* o = (GAS f4_t*)(out + (size_t)(m + r) * 1024) + lane;
#pragma unroll
        for (int j = 0; j < 4; ++j) __builtin_nontemporal_store(v[j] * inv * gg[j], o + 64 * j); }
}
template <int NR> __device__ __forceinline__ void final_rows(int m, int lane, const bf16_t* x1, const bf16_t* y, const float* fn, float* out) {
    unsigned long long xa[NR][4]; final_rows_loadx<NR>(m, lane, x1, xa); final_rows_rest<NR>(m, lane, xa, y, fn, out);
}
}
struct Args { const float* in[21]; float* out; unsigned char* ws; int ph_lo, ph_hi, li, pad; };
__global__ void __launch_bounds__(512, 2) mega(Args args) {
    extern __shared__ __attribute__((aligned(16))) unsigned char lds[];
    const int tid = threadIdx.x, lane = tid & 63, wave = __builtin_amdgcn_readfirstlane(tid >> 6);
    const int G = gridDim.x, bx = blockIdx.x, vcu = (G % 8 == 0) ? (bx % 8) * (G / 8) + bx / 8 : bx;
    LAS unsigned char* L = (LAS unsigned char*)lds;
    for (int u = tid; u < (LDS_BYTES - LDSCTL_OFF) / 4; u += 512) ((LAS unsigned*)(L + LDSCTL_OFF))[u] = 0u;
    __syncthreads();
    unsigned char* ws = args.ws;
    unsigned* ctl = (unsigned*)(ws + WS_CTL);
    XcdBarrier bar = xcd_barrier_post(ctl + CW_BAR + args.li * XCD_BAR_WORDS, (volatile LAS unsigned*)(L + MISC_OFF) + 8);
    const int lo = args.ph_lo, hi = args.ph_hi;
#define IN(k) (lo <= (k) && (k) < hi)
#define BOTH(k) (IN(k) && IN((k) + 1))
    const float* x = args.in[0];
    bf16_t* Wt_in = (bf16_t*)(ws + WS_WIN); bf16_t* Wt_out = (bf16_t*)(ws + WS_WOUT);
    bf16_t* hn = (bf16_t*)(ws + WS_X1 + 32 * MiB);
    float* rowinv = (float*)(ws + WS_RT + 320 * 1024);
    const int gw = vcu * 8 + wave, NGW = G * 8;
#ifndef CONV_PRE
#define CONV_PRE 4
#endif
#ifndef CONV_W
#define CONV_W 4
#endif
    auto conv_linear = [&](int I) { if (I < 6144) { const int ln = fresh_lane(); const int q = I >> 1, h = I & 1;
            const int it = q < 2048 ? ((q >> 6) * 128 + ((q >> 5) & 1) * 64 + h * 32 + (q & 31)) : (4096 + 2 * (q - 2048) + h);
            const moe::ConvP p = moe::conv_decode(it, args.in[17], args.in[18], args.in[19], args.in[12], (bf16_t*)(ws + WS_W1F), (bf16_t*)(ws + WS_W2F));
            moe::f4_t v[16]; moe::conv_load(p, ln, v); moe::conv_finish(p, ln, (LAS unsigned*)(L + 84480 + wave * 4352), v); } };
#ifndef CONV_MASK
#define CONV_MASK 15
#endif
    constexpr int CONV_LEFT = 512 * CONV_PRE + __builtin_popcount(CONV_MASK) * 256 * CONV_W;
    auto conv_slice = [&](int s) { if (G == 256 && wave <= CONV_W && ((CONV_MASK >> s) & 1)) conv_linear(512 * CONV_PRE + __builtin_popcount(CONV_MASK & ((1 << s) - 1)) * 256 * CONV_W + vcu * CONV_W + (wave - 1)); };
    if (IN(0)) {
        LAS float* scr = (LAS float*)(L + wave * 16384);
        constexpr int I_IN = 88 * 16, I_OUT = 32 * 16;
        for (int it = gw; it < I_IN + I_OUT; it += NGW) {
            if (it < I_IN) { const int kb = it / 88, nb = it % 88, n0 = nb * 32;
                int src = n0, nv = 32; if (n0 >= 1536 && n0 < 2560) src = n0 + 8; else if (n0 == 2560) { src = 1536; nv = 8; } else if (n0 > 2560) { src = 0; nv = 0; }
                p0_transpose_item(args.in[2], DM, INC, src, nv, Wt_in, n0, kb * 64, scr, lane, args.in[1]); }
            else { const int r = it - I_IN, kb = r / 32, nb = r % 32;
                p0_transpose_item(args.in[11], DM, DM, nb * 32, 32, Wt_out, nb * 32, kb * 64, scr, lane, nullptr); }
        }
        for (int it = 6144 + gw; it < moe::CONV_ITEMS; it += NGW) moe::convert_item(it, lane, (LAS unsigned*)(L + 84480 + wave * 4352), args.in[17], args.in[18], args.in[19], args.in[13], args.in[15], args.in[12], (bf16_t*)(ws + WS_W1F), (bf16_t*)(ws + WS_W2F), (bf16_t*)(ws + WS_WR));
        for (int it = gw; it < 16; it += NGW) lru::convert_item(it, lane, args.in[6], args.in[8], (bf16_t*)(ws + WS_WLRU));
        for (int m = gw; m < NTOK; m += NGW) row_to_bf16_inv(x + (size_t)m * DM, hn + (size_t)m * DM, rowinv + m, lane);
        if (BOTH(0)) xcd_barrier_work(bar, wave, [&] { conv_slice(0); });
    }
    if (IN(1)) {
        pg8::Gemm g{hn, Wt_in, NTOK, NIN, DM}; pg8::StaticOrder S; S.init(NTOK, NIN, G, bx);
        pg8::EpiInProj E{(bf16_t*)(ws + WS_Q), (bf16_t*)(ws + WS_K), (bf16_t*)(ws + WS_V), (bf16_t*)(ws + WS_GG), (bf16_t*)(ws + WS_RI), (float*)(ws + WS_LF), args.in[3], rowinv};
        pg8::gemm_phase<pg8::EpiInProj, pg8::StaticOrder, true, true>(L, g, S, E);
        if (G == 256 && bx >= 192) { __syncthreads(); for (int r = 0; r < CONV_PRE; ++r) conv_linear(r * 512 + (bx - 192) * 8 + wave); }
        if (BOTH(1)) xcd_barrier_work(bar, wave, [&] { conv_slice(1); });
    }
    if (IN(2)) { const int lane = fresh_lane();
        f32x16 Pc[2][2], Hl[2][2];
        LAS unsigned char* Lw = L + wave * lru::WAVE_LDS;
        float* sumP = (float*)(ws + WS_SUM); float* sumH = sumP + 256 * 512;
        const bool act = bx < 256;
        if (act) lru::stage1(bx, wave, lane, Lw, (const bf16_t*)(ws + WS_RI), (const bf16_t*)(ws + WS_WLRU), args.in[4], args.in[5], args.in[7], args.in[9], args.in[10], sumP, sumH, Pc, Hl);
        v4u gvp[8];
        asm volatile("s_waitcnt vmcnt(0)" ::: "memory");
        __syncthreads();
        if (wave == 0) { if (threadIdx.x == 0) xcd_barrier_thread0(bar); }
        if (act) lru::stage2_loadg(bx, wave, lane, (const bf16_t*)(ws + WS_GG), gvp);
        __syncthreads();
        if (act) lru::stage2(bx, wave, lane, Lw, gvp, (bf16_t*)(ws + WS_AO), sumP, sumH, Pc, Hl);
        __syncthreads();
    }
    if (IN(3)) {
        static_assert(attn_body::ATTN_LDS_BYTES <= LDSCTL_OFF, "attention LDS");
        const attn_body::AttnTensors AT{(const attn_body::bf16*)(ws + WS_Q), (const attn_body::bf16*)(ws + WS_K), (const attn_body::bf16*)(ws + WS_V), (attn_body::bf16*)(ws + WS_AO), (const float*)(ws + WS_LF)};
        const attn_body::StaticOrder S(G, bx);
        attn_body::attn_phase<attn_body::StaticOrder, 80>((char*)lds, AT, S);
        if (BOTH(3)) xcd_barrier_work(bar, wave, [&] { conv_slice(2); });
    }
    if (IN(4)) {
        pg8::Gemm g{(const bf16_t*)(ws + WS_AO), Wt_out, NTOK, DM, DM}; pg8::StaticOrder S; S.init(NTOK, DM, G, bx);
        pg8::EpiOutProj E{hn, (bf16_t*)(ws + WS_X1), (float*)(ws + WS_SSQP)};
        pg8::gemm_phase<pg8::EpiOutProj, pg8::StaticOrder, true, true>(L, g, S, E);
        if (BOTH(4)) xcd_barrier_work(bar, wave, [&] { conv_slice(3); });
    }
    unsigned* ecnt = ctl + CW_CNT; unsigned* lists = (unsigned*)(ws + WS_LIST); float* tokinv = (float*)(ws + 170 * MiB); float* slotw = (float*)(ws + 172 * MiB);
    if (IN(5)) { const int lane = fresh_lane(), tid = wave * 64 + lane;
        for (int blk = bx; blk < NTOK / 64; blk += G) { if (blk != bx) __syncthreads();
            moe::route_block(blk, tid, wave, lane, L, (const bf16_t*)(ws + WS_X1), (const bf16_t*)(ws + WS_WR), (const float*)(ws + WS_SSQP), args.in[14], args.in[16], ecnt, lists, tokinv, slotw); }
        if (G == 256) { for (int I = CONV_LEFT + gw; I < 6144; I += NGW) conv_linear(I); }
        else { for (int it = gw; it < 6144; it += NGW) moe::convert_item(it, lane, (LAS unsigned*)(L + 84480 + wave * 4352), args.in[17], args.in[18], args.in[19], args.in[13], args.in[15], args.in[12], (bf16_t*)(ws + WS_W1F), (bf16_t*)(ws + WS_W2F), (bf16_t*)(ws + WS_WR)); }
        if (BOTH(5)) xcd_barrier(bar);
    }
    if (IN(6)) { const int lane = fresh_lane(), tid = wave * 64 + lane;
        moe::moe_phase(vcu, G, tid, wave, lane, L, (const bf16_t*)(ws + WS_X1), (const bf16_t*)(ws + WS_W1F), (const bf16_t*)(ws + WS_W2F), ecnt, lists, tokinv, slotw, (bf16_t*)(ws + WS_Y));
    }
    if (IN(7)) { const int ln = fresh_lane(); const int m0 = gw * 8;
        unsigned long long xa[8][4];
        if (IN(6)) {
            asm volatile("s_waitcnt vmcnt(0)" ::: "memory");
            __syncthreads();
            if (wave == 0) { if (threadIdx.x == 0) xcd_barrier_thread0(bar); }
            if (m0 < NTOK) moe::final_rows_loadx<8>(m0, ln, (const bf16_t*)(ws + WS_X1), xa);
            __syncthreads();
        } else if (m0 < NTOK) moe::final_rows_loadx<8>(m0, ln, (const bf16_t*)(ws + WS_X1), xa);
        if (m0 < NTOK) moe::final_rows_rest<8>(m0, ln, xa, (const bf16_t*)(ws + WS_Y), args.in[20], args.out);
        for (int m = m0 + NGW * 8; m < NTOK; m += NGW * 8) moe::final_rows<8>(m, ln, (const bf16_t*)(ws + WS_X1), (const bf16_t*)(ws + WS_Y), args.in[20], args.out);
    }
#undef IN
#undef BOTH
}
#ifndef PROBE_K
#define PROBE_K -1
#endif
#ifndef PROBE_FLAGS
#define PROBE_FLAGS 0
#endif
extern "C" void kernel_launch(void* const* d_in, const int* in_sizes, int n_in, void* d_out, int out_size, void* d_ws, size_t ws_size, hipStream_t stream) {
    static int grid = 0;
    if (grid == 0) {
        if (n_in != 21 || ws_size < WS_END) { fprintf(stderr, "kernel_launch: unexpected n_in %d / ws %zu\n", n_in, ws_size); grid = -1; return; }
        int dev = 0, cus = 0;
        if (hipGetDevice(&dev) != hipSuccess || hipDeviceGetAttribute(&cus, hipDeviceAttributeMultiprocessorCount, dev) != hipSuccess) { grid = -1; return; }
        if (hipFuncSetAttribute((const void*)mega, hipFuncAttributeMaxDynamicSharedMemorySize, LDS_BYTES) != hipSuccess) { grid = -1; return; }
        grid = cus;
    }
    if (grid < 0) return;
    (void)hipMemsetAsync((char*)d_ws + WS_CTL, 0, CTL_ZERO_BYTES, stream);
    Args a{};
    for (int i = 0; i < 21; ++i) a.in[i] = (const float*)d_in[i];
    a.out = (float*)d_out; a.ws = (unsigned char*)d_ws;
    unsigned char* ws = (unsigned char*)d_ws;
    if (PROBE_K >= 0) {
        a.ph_lo = 0; a.ph_hi = PROBE_K + 1; a.li = 0; a.pad = PROBE_FLAGS;
        hipLaunchKernelGGL(mega, dim3(grid), dim3(512), LDS_BYTES, stream, a);
        (void)hipMemsetAsync((char*)d_ws + WS_CTL, 0, CTL_ZERO_BYTES, stream);
    }
    a.ph_lo = 0; a.ph_hi = 8; a.li = 0; a.pad = 0;
    hipLaunchKernelGGL(mega, dim3(grid), dim3(512), LDS_BYTES, stream, a);
}
```
